# Optimizing an MI355X kernel written in HIP

```python
import jax, jax.numpy as jnp
from jax import lax
import numpy as np

D_MODEL = 1024
BATCH = 16
SEQ = 256
DEPTH = 1
DEC_BATCH = 4
DEC_SEQ = 4096
PAST_LEN = 256

GRID_W = 64
N_HEADS = 16
HEAD_DIM = 64
D_RWKV = N_HEADS * HEAD_DIM
D_CONV = D_MODEL
CONV_W = 3
D_DECAY_LORA = 64
D_AAA_LORA = 64
D_GATE_LORA = 128
D_FF = 4 * D_MODEL
N_BRANCH = 2
D_IN_PROJ = 3 * D_RWKV + 2 * D_DECAY_LORA + 2 * D_AAA_LORA + D_GATE_LORA + 3 * D_CONV + N_BRANCH * D_MODEL
EPS = 1e-6
LNX_EPS = 64e-5

kernel_name = 'bidir_rwkv7_shortconv_flow_step'


def _in_split_points():
    sizes = (D_RWKV, D_RWKV, D_RWKV, 2 * D_DECAY_LORA, 2 * D_AAA_LORA, D_GATE_LORA, D_CONV, D_CONV, D_CONV)
    pts, acc = [], 0
    for s in sizes:
        acc += s
        pts.append(acc)
    return pts


def rms_norm(x, g):
    xf = x.astype(jnp.float32)
    y = xf * lax.rsqrt(jnp.mean(xf * xf, axis=-1, keepdims=True) + EPS)
    return (y * g.astype(jnp.float32)).astype(x.dtype)


def ada_modulation(cvec, w_ada, b_ada):
    m = jax.nn.silu(cvec) @ w_ada + b_ada
    return jnp.split(m[..., None, :], 6, axis=-1)


def centred_conv3(u, w):
    L = u.shape[-2]
    pad = [(0, 0)] * (u.ndim - 2) + [(1, 1), (0, 0)]
    up = jnp.pad(u, pad)
    return w[0] * up[..., 0:L, :] + w[1] * up[..., 1:L + 1, :] + w[2] * up[..., 2:L + 2, :]


def to_heads(u):
    return u.reshape(u.shape[:-1] + (N_HEADS, HEAD_DIM))


def wkv_scan(s0, r, w, k, v, a, b, reverse):
    def seq_major(u):
        return jnp.moveaxis(to_heads(u.astype(jnp.float32)), 1, 0)

    def step(S, inp):
        r_t, w_t, k_t, v_t, a_t, b_t = inp
        sa = jnp.einsum('bhvk,bhk->bhv', S, a_t)
        S = S * w_t[:, :, None, :] + sa[..., None] * b_t[:, :, None, :] + v_t[..., None] * k_t[:, :, None, :]
        return S, jnp.einsum('bhvk,bhk->bhv', S, r_t)

    s_final, y = lax.scan(step, s0.astype(jnp.float32),
                          (seq_major(r), seq_major(w), seq_major(k), seq_major(v), seq_major(a), seq_major(b)),
                          reverse=reverse)
    return jnp.moveaxis(y, 0, 1), s_final.astype(s0.dtype)


def token_mixer(xn, s0_f, s0_b, p, on_grid):
    B, T, _ = xn.shape
    z = xn @ p['w_in']
    r, k, v, wl, al, gl, cb, cc, ch, zg = jnp.split(z, _in_split_points(), axis=-1)

    g_out = jax.nn.sigmoid(gl) @ p['g2']
    kk = to_heads((k * p['k_k']).astype(jnp.float32))
    kk = kk * lax.rsqrt(jnp.maximum(jnp.sum(kk * kk, axis=-1, keepdims=True), 1e-12))
    kk = kk.reshape(B, T, D_RWKV)
    rh = to_heads(r.astype(jnp.float32))
    vh = to_heads(v.astype(jnp.float32))
    ys, bonuses, states = [], [], []
    for d, (s0, reverse) in enumerate(((s0_f, False), (s0_b, True))):
        wl_d = wl[..., d * D_DECAY_LORA:(d + 1) * D_DECAY_LORA]
        al_d = al[..., d * D_AAA_LORA:(d + 1) * D_AAA_LORA]
        w_log = -jax.nn.softplus(-(p['w0'][d] + jnp.tanh(wl_d) @ p['w2'][d])) - 0.5
        decay = jnp.exp(-jnp.exp(w_log.astype(jnp.float32)))
        a = jax.nn.sigmoid(p['a0'][d] + al_d @ p['a2'][d])
        kd = k * (1.0 + (a - 1.0) * p['k_a'])
        y_d, s_d = wkv_scan(s0, r, decay, kd, v, -kk, kk * a, reverse)
        ys.append(y_d)
        bonuses.append(jnp.sum(rh * to_heads(kd.astype(jnp.float32)) * p['r_k'], axis=-1, keepdims=True) * vh)
        states.append(s_d)
    wkv = ys[0] + ys[1]
    mu = jnp.mean(wkv, axis=-1, keepdims=True)
    var = jnp.mean(jnp.square(wkv - mu), axis=-1, keepdims=True)
    ln = ((wkv - mu) * lax.rsqrt(var + LNX_EPS)).reshape(B, T, D_RWKV) * p['lnx_w'] + p['lnx_b']
    x_a = (ln + (bonuses[0] + bonuses[1]).reshape(B, T, D_RWKV)).astype(xn.dtype) * g_out
    y_a = x_a @ p['w_pa']

    u = cc * ch
    if on_grid:
        rows = T // GRID_W
        conv_u = centred_conv3(u.reshape(B, rows, GRID_W, D_CONV), p['conv_w']).reshape(B, T, D_CONV)
    else:
        conv_u = centred_conv3(u, p['conv_w'])
    y_b = (cb * conv_u) @ p['w_pb']

    gate_a, gate_b = jnp.split(jax.nn.sigmoid(zg), 2, axis=-1)
    out = (gate_a * y_a + gate_b * y_b) @ p['w_o']
    return out, states[0], states[1]


def layer_apply(x, cvec, s0_f, s0_b, p, on_grid):
    sh1, sc1, gt1, sh2, sc2, gt2 = ada_modulation(cvec, p['w_ada'], p['b_ada'])
    xn = rms_norm(x, p['norm1_g']) * (1.0 + sc1) + sh1
    mix, s_f, s_b = token_mixer(xn, s0_f, s0_b, p, on_grid)
    x = x + gt1 * mix
    xn = rms_norm(x, p['norm2_g']) * (1.0 + sc2) + sh2
    x = x + gt2 * (jnp.square(jax.nn.relu(xn @ p['w_ff1'])) @ p['w_ff2'])
    return x, s_f, s_b


def setup_inputs(seed: int = 0) -> dict:
    key = jax.random.key(seed)
    ks = jax.random.split(key, 32)

    def nrm(i, shape, scale):
        return scale * jax.random.normal(ks[i], shape, dtype=jnp.float32)

    st_shape = (DEC_BATCH, DEPTH, N_HEADS, HEAD_DIM, HEAD_DIM)
    return {
        'x_prompt': nrm(0, (BATCH, SEQ, D_MODEL), 1.0),
        'x_sample': nrm(1, (DEC_BATCH, DEC_SEQ, D_MODEL), 1.0),
        'state_rwkv_fwd': nrm(2, st_shape, 0.5),
        'state_rwkv_bwd': nrm(3, st_shape, 0.5),
        'c': nrm(4, (DEC_BATCH, D_MODEL), 1.0),
        'c_ctx': nrm(5, (D_MODEL,), 1.0),
        'norm1_g': 1.0 + nrm(6, (DEPTH, D_MODEL), 0.05),
        'norm2_g': 1.0 + nrm(7, (DEPTH, D_MODEL), 0.05),
        'w_ada': nrm(8, (DEPTH, D_MODEL, 6 * D_MODEL), 0.5 * D_MODEL ** -0.5),
        'b_ada': nrm(9, (DEPTH, 6 * D_MODEL), 0.02),
        'w_in': nrm(10, (DEPTH, D_MODEL, D_IN_PROJ), D_MODEL ** -0.5),
        'w0': -1.0 + nrm(11, (DEPTH, 2, D_RWKV), 0.3),
        'w2': nrm(12, (DEPTH, 2, D_DECAY_LORA, D_RWKV), 0.1),
        'a0': nrm(13, (DEPTH, 2, D_RWKV), 0.1),
        'a2': nrm(14, (DEPTH, 2, D_AAA_LORA, D_RWKV), 0.5 * D_AAA_LORA ** -0.5),
        'g2': nrm(15, (DEPTH, D_GATE_LORA, D_RWKV), D_GATE_LORA ** -0.5),
        'k_k': 0.85 + nrm(16, (DEPTH, D_RWKV), 0.05),
        'k_a': 1.0 + nrm(17, (DEPTH, D_RWKV), 0.05),
        'r_k': nrm(18, (DEPTH, N_HEADS, HEAD_DIM), 0.1),
        'lnx_w': 1.0 + nrm(19, (DEPTH, D_RWKV), 0.05),
        'lnx_b': nrm(20, (DEPTH, D_RWKV), 0.02),
        'conv_w': nrm(21, (DEPTH, CONV_W, D_CONV), CONV_W ** -0.5),
        'w_pa': nrm(22, (DEPTH, D_RWKV, D_MODEL), D_RWKV ** -0.5),
        'w_pb': nrm(23, (DEPTH, D_CONV, D_MODEL), D_CONV ** -0.5),
        'w_o': nrm(24, (DEPTH, D_MODEL, D_MODEL), D_MODEL ** -0.5),
        'w_ff1': nrm(25, (DEPTH, D_MODEL, D_FF), D_MODEL ** -0.5),
        'w_ff2': nrm(26, (DEPTH, D_FF, D_MODEL), D_FF ** -0.5),
        'final_norm_g': 1.0 + nrm(27, (D_MODEL,), 0.05),
    }


def reference(x_prompt, x_sample, state_rwkv_fwd, state_rwkv_bwd, c, c_ctx,
              norm1_g, norm2_g, w_ada, b_ada, w_in, w0, w2, a0, a2, g2, k_k, k_a, r_k,
              lnx_w, lnx_b, conv_w, w_pa, w_pb, w_o, w_ff1, w_ff2, final_norm_g):
    stacked = dict(norm1_g=norm1_g, norm2_g=norm2_g, w_ada=w_ada, b_ada=b_ada, w_in=w_in,
                   w0=w0, w2=w2, a0=a0, a2=a2, g2=g2, k_k=k_k, k_a=k_a, r_k=r_k,
                   lnx_w=lnx_w, lnx_b=lnx_b, conv_w=conv_w, w_pa=w_pa, w_pb=w_pb, w_o=w_o,
                   w_ff1=w_ff1, w_ff2=w_ff2)

    h = x_prompt
    zero_state = jnp.zeros((x_prompt.shape[0], N_HEADS, HEAD_DIM, HEAD_DIM), x_prompt.dtype)
    fwd_states, bwd_states = [], []
    for l in range(DEPTH):
        p = {name: arr[l] for name, arr in stacked.items()}
        h, s_f, s_b = layer_apply(h, c_ctx, zero_state, zero_state, p, False)
        fwd_states.append(s_f)
        bwd_states.append(s_b)
    y_prompt = rms_norm(h, final_norm_g)
    new_state_fwd = jnp.stack(fwd_states, axis=1)
    new_state_bwd = jnp.stack(bwd_states, axis=1)

    g = x_sample
    for l in range(DEPTH):
        p = {name: arr[l] for name, arr in stacked.items()}
        g, _, _ = layer_apply(g, c, state_rwkv_fwd[:, l], state_rwkv_bwd[:, l], p, True)
    y_sample = rms_norm(g, final_norm_g)

    return (y_prompt, y_sample, new_state_fwd, new_state_bwd)
```

```cpp
#include <hip/hip_runtime.h>
#include <hip/hip_cooperative_groups.h>
#include <cstdio>
namespace cg = cooperative_groups;

#define LAS __attribute__((address_space(3)))
typedef unsigned short bf16_t;
typedef short bf16x8 __attribute__((ext_vector_type(8)));
typedef float f32x4 __attribute__((ext_vector_type(4)));
typedef unsigned u32x4 __attribute__((ext_vector_type(4)));
typedef unsigned u32x2 __attribute__((ext_vector_type(2)));

constexpr int NT = 20480;
constexpr int NCTX = 4096;
constexpr int DM = 1024;
constexpr size_t RG = (size_t)NT * DM * 2;
constexpr size_t WS_R = 0, WS_K = RG, WS_CB = 2 * RG, WS_U = 3 * RG, WS_V = 4 * RG;
constexpr size_t WS_LOR = 5 * RG;
constexpr size_t WS_WIN = WS_LOR + (size_t)NT * 384 * 2;
constexpr size_t WS_WPA = WS_WIN + (size_t)8704 * 1024 * 2;
constexpr size_t WS_WPB = WS_WPA + (size_t)1024 * 1024 * 2;
constexpr size_t WS_WO = WS_WPB + (size_t)1024 * 1024 * 2;
constexpr size_t WS_W2T = WS_WO + (size_t)1024 * 1024 * 2;
constexpr size_t WS_A2T = WS_W2T + (size_t)2 * 1024 * 64 * 2;
constexpr size_t WS_G2T = WS_A2T + (size_t)2 * 1024 * 64 * 2;
constexpr size_t WS_MODP = WS_G2T + (size_t)1024 * 128 * 2;
constexpr size_t WS_MOD = WS_MODP + (size_t)32 * 5 * 6144 * 4;
constexpr size_t WS_C3 = WS_MOD + (size_t)5 * 6144 * 4;
constexpr size_t WS_BAR = WS_C3 + (size_t)2 * NT * 16 * 4;
constexpr size_t WS_END = WS_BAR + (size_t)3456 * 4;
constexpr size_t WS_WFF1 = WS_WIN, WS_WFF2 = WS_END;
constexpr int XST_OFF = 151040;
constexpr int SC_TT = XST_OFF + 16;
constexpr int LDS_BYTES = SC_TT + 2 * 4224;
#ifndef REP_SCAN
#define REP_SCAN 1
#endif
#ifndef REP_P2
#define REP_P2 1
#endif
#ifndef REP_P12
#define REP_P12 1
#endif
#ifndef REP_P7
#define REP_P7 1
#endif
#ifndef REP_P0
#define REP_P0 1
#endif


struct Params {
  const float* in[28];
  float* out;
  unsigned char* ws;
};

__device__ __forceinline__ float bf2f(unsigned b) { return __uint_as_float(b << 16); }
typedef __bf16 bf16v2_t __attribute__((ext_vector_type(2)));
typedef float f32v2_t __attribute__((ext_vector_type(2)));
__device__ __forceinline__ unsigned cvt_pk_bf16(float lo, float hi) { const f32v2_t f = {lo, hi}; const bf16v2_t r = __builtin_convertvector(f, bf16v2_t); return __builtin_bit_cast(unsigned, r); }
__device__ __forceinline__ float lo_bf(unsigned u) { return __uint_as_float(u << 16); }
__device__ __forceinline__ float hi_bf(unsigned u) { return __uint_as_float(u & 0xffff0000u); }
__device__ __forceinline__ float sigmoidf_(float x) { return __builtin_amdgcn_rcpf(1.0f + __expf(-x)); }
template <int CTRL> __device__ __forceinline__ float dppf(float x) {
  return __int_as_float(__builtin_amdgcn_update_dpp(0, __float_as_int(x), CTRL, 0xF, 0xF, true));
}
template <int CTRL> __device__ __forceinline__ float dppo(float oldv, float x) {
  return __int_as_float(__builtin_amdgcn_update_dpp(__float_as_int(oldv), __float_as_int(x), CTRL, 0xF, 0xF, false));
}
__device__ __forceinline__ float sum8(float x) { x += dppf<0xB1>(x); x += dppf<0x4E>(x); x += dppf<0x141>(x); return x; }
__device__ __forceinline__ float sum16(float x) { x = sum8(x); x += dppf<0x140>(x); return x; }
__device__ __forceinline__ float wave_sum(float x) {
  x = sum16(x); x += __shfl_xor(x, 16); x += __shfl_xor(x, 32); return x;
}
__device__ __forceinline__ int opaque_tid() { int t = threadIdx.x; asm volatile("" : "+v"(t)); return t; }
__device__ __forceinline__ __amdgpu_buffer_rsrc_t wt_rsrc(const void* base) { return __builtin_amdgcn_make_buffer_rsrc(const_cast<void*>(base), 0, 0x7fffffff, 0x00020000); }
__device__ __forceinline__ void st16_wt(const __amdgpu_buffer_rsrc_t& rs, const void* base, const void* p, u32x4 v) {
  __builtin_amdgcn_raw_buffer_store_b128(v, rs, (unsigned)((const char*)p - (const char*)base), 0, 16); }
__device__ __forceinline__ void st8_wt(const __amdgpu_buffer_rsrc_t& rs, const void* base, const void* p, u32x2 v) {
  __builtin_amdgcn_raw_buffer_store_b64(v, rs, (unsigned)((const char*)p - (const char*)base), 0, 16); }
__device__ __forceinline__ int mod_index(int row) { return row < NCTX ? 0 : 1 + ((row - NCTX) >> 12); }

namespace pg8 {
constexpr int BM = 256, BK = 64, HALF = 128, HTB = HALF * BK * 2, STAGE_BYTES = 8 * HTB, NXCD = 8, WGM = 8;
__device__ __forceinline__ int lds_byte(int r, int c) { const int st = (r >> 4) * 2 + (c >> 5), rr = r & 15, cc = c & 31, ob = rr * 64 + cc * 2; return st * 1024 + (ob ^ (((ob >> 9) & 1) << 5)); }
__device__ __forceinline__ void stage_rc(int b, int& R, int& C) { const int st = b / 1024, sb = b % 1024, swz = sb ^ (((sb >> 9) & 1) << 5); R = (st >> 1) * 16 + swz / 64; C = (st & 1) * 32 + (swz % 64) / 2; }
__device__ __forceinline__ int perm32(int rho) { const int n = rho >> 4, i = rho & 15; return 8 * (i >> 2) + 4 * n + (i & 3); }
struct Unit { int pm, pn, ks; };
struct Gemm { const bf16_t* A; const bf16_t* Bt; int M, N, K, ld; const bf16_t* A2 = nullptr; const bf16_t* Bt2 = nullptr; int nsplit = 1 << 30; };
struct StaticOrder {
  int nM, nN, nwg, G, c, nNr;
  __device__ void init(int M, int N, int G_, int c_, int ksplit = 1) { nM = M / BM; nNr = N / BM; nN = nNr * ksplit; nwg = nM * nN; G = G_; c = c_; }
  __device__ bool next(int i, Unit& u) const {
    const long L = (long)i * G + c; if (L >= nwg) return false;
    int wgid = (int)L; { const int q = nwg / NXCD, r = nwg % NXCD, xcd = wgid % NXCD, off = wgid / NXCD; wgid = (xcd < r ? xcd * (q + 1) : r * (q + 1) + (xcd - r) * q) + off; }
    const int nig = WGM * nN, gid = wgid / nig, fm = gid * WGM, gsz = (nM - fm) < WGM ? (nM - fm) : WGM;
    u.pm = fm + ((wgid % nig) % gsz); const int pv = (wgid % nig) / gsz; u.pn = pv % nNr; u.ks = pv / nNr; return true;
  }
};
template <class Epi>
__device__ __forceinline__ void gemm_phase(LAS unsigned char* lds, const Gemm g, const StaticOrder& S, const Epi& E) {
  const int tid = opaque_tid(), wid = __builtin_amdgcn_readfirstlane(tid >> 6), lane = tid & 63, wr = wid >> 2, wc = wid & 3, fr = lane & 15, fq = lane >> 4;
  const int K = g.K, nt = K / BK, LD = g.ld;
  unsigned voffA[2], voffB[2];
#pragma unroll
  for (int i = 0; i < 2; ++i) { int R, C; stage_rc(tid * 16 + i * 8192, R, C); const int Rb = Epi::PERM ? ((R & ~31) + perm32(R & 31)) : R;
    voffA[i] = (unsigned)(R * LD + C) * 2u; voffB[i] = (unsigned)(Rb * LD + C) * 2u; }
  const size_t kstep = (size_t)(BK * 2);
  const size_t hstep = (size_t)HALF * LD * 2;
  const size_t ksb = (size_t)K * 2;
  const size_t tstep = 2 * hstep;
  const unsigned ldsw = (unsigned)wid * 1024u;
  const int aoff = lds_byte(wr * 64 + fr, fq * 8), boff = lds_byte(wc * 32 + fr, fq * 8);
#define PG8_SA(b, h) (((b) * 2 + (h)) * HTB)
#define PG8_SB(b, h) ((4 + (b) * 2 + (h)) * HTB)
#define PG8_STAGE(bufoff, gbase, voff) do { _Pragma("unroll") for (int _i = 0; _i < 2; ++_i) \
    __builtin_amdgcn_global_load_lds((const unsigned*)((const char*)(gbase) + (voff)[_i]), (LAS unsigned*)(lds + (bufoff) + ldsw + _i * 8192), 16, 0, 0); } while (0)
#define PG8_LDA(dst, b, h) do { _Pragma("unroll") for (int m = 0; m < 4; ++m) _Pragma("unroll") for (int k = 0; k < 2; ++k) dst[m][k] = *(const LAS bf16x8*)(lds + PG8_SA(b, h) + aoff + m * 2048 + k * 1024); } while (0)
#define PG8_LDB(dst, b, h) do { _Pragma("unroll") for (int n = 0; n < 2; ++n) _Pragma("unroll") for (int k = 0; k < 2; ++k) dst[n][k] = *(const LAS bf16x8*)(lds + PG8_SB(b, h) + boff + n * 2048 + k * 1024); } while (0)
#define PG8_MMA(ai, bj, At, Bt) do { __builtin_amdgcn_s_setprio(1); _Pragma("unroll") for (int m = 0; m < 4; ++m) _Pragma("unroll") for (int n = 0; n < 2; ++n) _Pragma("unroll") for (int k = 0; k < 2; ++k) \
    acc[ai][bj][m][n] = __builtin_amdgcn_mfma_f32_16x16x32_bf16(Bt[n][k], At[m][k], acc[ai][bj][m][n], 0, 0, 0); __builtin_amdgcn_s_setprio(0); } while (0)
#define PG8_WAIT_V(n) asm volatile("s_waitcnt vmcnt(" #n ")" ::: "memory")
#define PG8_WAIT_L(n) asm volatile("s_waitcnt lgkmcnt(" #n ")" ::: "memory")
#define PG8_BAR __builtin_amdgcn_s_barrier()
#define PG8_SCHED __builtin_amdgcn_sched_barrier(0)
  Unit cur, nxt; int ui = 0;
  if (!S.next(0, cur)) return;
  f32x4 acc[2][2][4][2];
#pragma unroll
  for (int a = 0; a < 2; ++a)
#pragma unroll
    for (int b = 0; b < 2; ++b)
#pragma unroll
      for (int m = 0; m < 4; ++m)
#pragma unroll
        for (int n = 0; n < 2; ++n) acc[a][b][m][n] = (f32x4){0.f, 0.f, 0.f, 0.f};
  bf16x8 At[4][2], B0[2][2], B1[2][2];
  const long dA2 = g.A2 ? (long)((const char*)g.A2 - (const char*)g.A) : 0L;
  const long dB2 = g.Bt2 ? (long)((const char*)g.Bt2 - (const char*)g.Bt) - (long)g.nsplit * (long)tstep : 0L;
#define PG8_UA(u_) ((const char*)g.A + (size_t)(u_).pm * tstep + (size_t)(u_).ks * ksb + ((u_).pn >= g.nsplit ? dA2 : 0L))
#define PG8_UB(u_) ((const char*)g.Bt + (size_t)(u_).pn * tstep + (size_t)(u_).ks * ksb + ((u_).pn >= g.nsplit ? dB2 : 0L))
  const char* cA = PG8_UA(cur); const char* cB = PG8_UB(cur);
  PG8_STAGE(PG8_SB(0, 0), cB, voffB); PG8_STAGE(PG8_SA(0, 0), cA, voffA); PG8_STAGE(PG8_SB(0, 1), cB + hstep, voffB); PG8_STAGE(PG8_SA(0, 1), cA + hstep, voffA);
  if (wr == 1) PG8_BAR;
  PG8_WAIT_V(4); PG8_BAR;
  PG8_STAGE(PG8_SB(1, 0), cB + kstep, voffB); PG8_STAGE(PG8_SA(1, 0), cA + kstep, voffA); PG8_STAGE(PG8_SB(1, 1), cB + hstep + kstep, voffB);
  PG8_WAIT_V(6); PG8_BAR;
  for (;;) {
    const bool has_next = S.next(ui + 1, nxt);
    const char* nA = has_next ? PG8_UA(nxt) : cA; const char* nB = has_next ? PG8_UB(nxt) : cB;
    for (int t = 0; t < nt; t += 2) {
      const bool last = (t == nt - 2);
      const char* a1 = cA + (size_t)(t + 1) * kstep;
      const char* a2 = last ? nA : cA + (size_t)(t + 2) * kstep; const char* b2 = last ? nB : cB + (size_t)(t + 2) * kstep;
      const char* a3 = a2 + kstep; const char* b3 = b2 + kstep;
      PG8_LDB(B0, 0, 0); PG8_SCHED; PG8_LDA(At, 0, 0); PG8_STAGE(PG8_SA(1, 1), a1 + hstep, voffA);
      PG8_WAIT_L(8); PG8_BAR; PG8_WAIT_L(0); PG8_MMA(0, 0, At, B0); PG8_BAR; PG8_SCHED;
      PG8_LDB(B1, 0, 1); PG8_STAGE(PG8_SB(0, 0), b2, voffB);
      PG8_BAR; PG8_WAIT_L(0); PG8_MMA(0, 1, At, B1); PG8_BAR;
      PG8_LDA(At, 0, 1); PG8_STAGE(PG8_SA(0, 0), a2, voffA);
      PG8_BAR; PG8_WAIT_L(0); PG8_MMA(1, 0, At, B0); PG8_BAR; PG8_SCHED;
      PG8_STAGE(PG8_SB(0, 1), b2 + hstep, voffB);
      PG8_WAIT_V(6); PG8_BAR; PG8_MMA(1, 1, At, B1); PG8_BAR;
      PG8_LDB(B0, 1, 0); PG8_SCHED; PG8_LDA(At, 1, 0); PG8_STAGE(PG8_SA(0, 1), a2 + hstep, voffA);
      PG8_WAIT_L(8); PG8_BAR; PG8_WAIT_L(0); PG8_MMA(0, 0, At, B0); PG8_BAR; PG8_SCHED;
      PG8_LDB(B1, 1, 1); PG8_STAGE(PG8_SB(1, 0), b3, voffB);
      PG8_BAR; PG8_WAIT_L(0); PG8_MMA(0, 1, At, B1); PG8_BAR;
      PG8_LDA(At, 1, 1); PG8_STAGE(PG8_SA(1, 0), a3, voffA);
      PG8_BAR; PG8_WAIT_L(0); PG8_MMA(1, 0, At, B0); PG8_BAR; PG8_SCHED;
      PG8_STAGE(PG8_SB(1, 1), b3 + hstep, voffB);
      PG8_WAIT_V(6); PG8_BAR; PG8_MMA(1, 1, At, B1); PG8_BAR;
    }
    E(acc, cur, wr, wc, fr, fq);
    if (!has_next) break;
#pragma unroll
    for (int a = 0; a < 2; ++a)
#pragma unroll
      for (int b = 0; b < 2; ++b)
#pragma unroll
        for (int m = 0; m < 4; ++m)
#pragma unroll
          for (int n = 0; n < 2; ++n) acc[a][b][m][n] = (f32x4){0.f, 0.f, 0.f, 0.f};
    cur = nxt; cA = nA; cB = nB; ++ui;
  }
  PG8_WAIT_V(0);
  if (wr == 0) PG8_BAR;
  PG8_BAR;
#undef PG8_UA
#undef PG8_UB
#undef PG8_SA
#undef PG8_SB
#undef PG8_STAGE
#undef PG8_LDA
#undef PG8_LDB
#undef PG8_MMA
#undef PG8_WAIT_V
#undef PG8_WAIT_L
#undef PG8_BAR
#undef PG8_SCHED
}
}
using pg8::Unit;
typedef f32x4 AccT[2][2][4][2];

struct EpiIn {
  static constexpr bool PERM = true;
  bf16_t *R, *K, *V, *CB, *U, *LOR;
  __device__ __forceinline__ void operator()(const AccT& acc, const Unit& u, int wr, int wc, int fr, int fq) const {
    const int row0 = u.pm * 256 + wr * 64 + fr;
    const __amdgpu_buffer_rsrc_t rs = wt_rsrc(R);
    if (u.pn < 16) {
      bf16_t* base = (u.pn < 4) ? R : (u.pn < 8) ? K : (u.pn < 12) ? V : CB;
      const int col0 = (u.pn & 3) * 256 + wc * 32 + 8 * fq;
#pragma unroll
      for (int ai = 0; ai < 2; ++ai)
#pragma unroll
        for (int m = 0; m < 4; ++m) { bf16_t* rowp = base + (size_t)(row0 + ai * 128 + m * 16) * DM + col0;
#pragma unroll
          for (int bj = 0; bj < 2; ++bj) { const f32x4 v0 = acc[ai][bj][m][0], v1 = acc[ai][bj][m][1];
            u32x4 o; o[0] = cvt_pk_bf16(v0[0], v0[1]); o[1] = cvt_pk_bf16(v0[2], v0[3]); o[2] = cvt_pk_bf16(v1[0], v1[1]); o[3] = cvt_pk_bf16(v1[2], v1[3]);
            st16_wt(rs, R, rowp + bj * 128, o); } }
    } else if (u.pn < 24) {
      const int ch0 = (u.pn - 16) * 128 + wc * 16 + 4 * fq;
#pragma unroll
      for (int ai = 0; ai < 2; ++ai)
#pragma unroll
        for (int m = 0; m < 4; ++m) { bf16_t* rowp = U + (size_t)(row0 + ai * 128 + m * 16) * DM + ch0;
#pragma unroll
          for (int bj = 0; bj < 2; ++bj) { const f32x4 p = acc[ai][bj][m][0] * acc[ai][bj][m][1];
            u32x2 o; o[0] = cvt_pk_bf16(p[0], p[1]); o[1] = cvt_pk_bf16(p[2], p[3]);
            st8_wt(rs, R, rowp + bj * 64, o); } }
    } else {
      const int colw = wc * 32 + 8 * fq;
#pragma unroll
      for (int ai = 0; ai < 2; ++ai)
#pragma unroll
        for (int m = 0; m < 4; ++m) { bf16_t* rowp = LOR + (size_t)(row0 + ai * 128 + m * 16) * 384;
#pragma unroll
          for (int bj = 0; bj < 2; ++bj) {
            f32x4 v0 = acc[ai][bj][m][0], v1 = acc[ai][bj][m][1];
            if (u.pn == 24) {
              if (bj == 0) {
#pragma unroll
                for (int j = 0; j < 4; ++j) { v0[j] = 1.0f - 2.0f * __builtin_amdgcn_rcpf(1.0f + __expf(2.0f * v0[j])); v1[j] = 1.0f - 2.0f * __builtin_amdgcn_rcpf(1.0f + __expf(2.0f * v1[j])); }
              }
              u32x4 o; o[0] = cvt_pk_bf16(v0[0], v0[1]); o[1] = cvt_pk_bf16(v0[2], v0[3]); o[2] = cvt_pk_bf16(v1[0], v1[1]); o[3] = cvt_pk_bf16(v1[2], v1[3]);
              *(u32x4*)(rowp + bj * 128 + colw) = o;
            } else if (bj == 0) {
#pragma unroll
              for (int j = 0; j < 4; ++j) { v0[j] = sigmoidf_(v0[j]); v1[j] = sigmoidf_(v1[j]); }
              u32x4 o; o[0] = cvt_pk_bf16(v0[0], v0[1]); o[1] = cvt_pk_bf16(v0[2], v0[3]); o[2] = cvt_pk_bf16(v1[0], v1[1]); o[3] = cvt_pk_bf16(v1[2], v1[3]);
              *(u32x4*)(rowp + 256 + colw) = o;
            }
          } }
    }
  }
};
struct EpiGate {
  static constexpr bool PERM = true;
  bf16_t *GA, *GB, *YR;
  __device__ __forceinline__ void operator()(const AccT& acc, const Unit& u, int wr, int wc, int fr, int fq) const {
    const int row0 = u.pm * 256 + wr * 64 + fr;
    long boff = 0L; if (u.pn >= 4) boff = (long)((char*)GB - (char*)GA); if (u.pn >= 8) boff = (long)((char*)YR - (char*)GA);
    bf16_t* base = (bf16_t*)((char*)GA + boff);
    const bool sg = u.pn < 8;
    const int col0 = (u.pn & 3) * 256 + wc * 32 + 8 * fq;
#pragma unroll
    for (int ai = 0; ai < 2; ++ai)
#pragma unroll
      for (int m = 0; m < 4; ++m) { bf16_t* rowp = base + (size_t)(row0 + ai * 128 + m * 16) * DM + col0;
#pragma unroll
        for (int bj = 0; bj < 2; ++bj) { f32x4 v0 = acc[ai][bj][m][0], v1 = acc[ai][bj][m][1];
          if (sg) {
#pragma unroll
            for (int j = 0; j < 4; ++j) { v0[j] = sigmoidf_(v0[j]); v1[j] = sigmoidf_(v1[j]); } }
          u32x4 o; o[0] = cvt_pk_bf16(v0[0], v0[1]); o[1] = cvt_pk_bf16(v0[2], v0[3]); o[2] = cvt_pk_bf16(v1[0], v1[1]); o[3] = cvt_pk_bf16(v1[2], v1[3]);
          *(u32x4*)(rowp + bj * 128) = o; } }
  }
};
struct EpiYa {
  static constexpr bool PERM = true;
  const bf16_t* GA; const bf16_t* GB; bf16_t* O;
  __device__ __forceinline__ void operator()(const AccT& acc, const Unit& u, int wr, int wc, int fr, int fq) const {
    const int row0 = u.pm * 256 + wr * 64 + fr; const int col0 = u.pn * 256 + wc * 32 + 8 * fq;
#pragma unroll
    for (int ai = 0; ai < 2; ++ai)
#pragma unroll
      for (int m = 0; m < 4; ++m) { const size_t off = (size_t)(row0 + ai * 128 + m * 16) * DM + col0;
#pragma unroll
        for (int bj = 0; bj < 2; ++bj) { const f32x4 v0 = acc[ai][bj][m][0], v1 = acc[ai][bj][m][1];
          const u32x4 ga = *(const u32x4*)(GA + off + bj * 128), gb = *(const u32x4*)(GB + off + bj * 128), yr = *(const u32x4*)(O + off + bj * 128);
          float r[8];
          r[0] = lo_bf(ga[0]) * v0[0] + lo_bf(gb[0]) * lo_bf(yr[0]); r[1] = hi_bf(ga[0]) * v0[1] + hi_bf(gb[0]) * hi_bf(yr[0]);
          r[2] = lo_bf(ga[1]) * v0[2] + lo_bf(gb[1]) * lo_bf(yr[1]); r[3] = hi_bf(ga[1]) * v0[3] + hi_bf(gb[1]) * hi_bf(yr[1]);
          r[4] = lo_bf(ga[2]) * v1[0] + lo_bf(gb[2]) * lo_bf(yr[2]); r[5] = hi_bf(ga[2]) * v1[1] + hi_bf(gb[2]) * hi_bf(yr[2]);
          r[6] = lo_bf(ga[3]) * v1[2] + lo_bf(gb[3]) * lo_bf(yr[3]); r[7] = hi_bf(ga[3]) * v1[3] + hi_bf(gb[3]) * hi_bf(yr[3]);
          u32x4 o; o[0] = cvt_pk_bf16(r[0], r[1]); o[1] = cvt_pk_bf16(r[2], r[3]); o[2] = cvt_pk_bf16(r[4], r[5]); o[3] = cvt_pk_bf16(r[6], r[7]);
          *(u32x4*)(O + off + bj * 128) = o; } }
  }
};
template <bool ADD> struct EpiY {
  static constexpr bool PERM = true;
  const bf16_t* G; bf16_t* O;
  __device__ __forceinline__ void operator()(const AccT& acc, const Unit& u, int wr, int wc, int fr, int fq) const {
    const int row0 = u.pm * 256 + wr * 64 + fr; const int col0 = u.pn * 256 + wc * 32 + 8 * fq;
#pragma unroll
    for (int ai = 0; ai < 2; ++ai)
#pragma unroll
      for (int m = 0; m < 4; ++m) { const size_t off = (size_t)(row0 + ai * 128 + m * 16) * DM + col0;
#pragma unroll
        for (int bj = 0; bj < 2; ++bj) { const f32x4 v0 = acc[ai][bj][m][0], v1 = acc[ai][bj][m][1];
          const u32x4 g = *(const u32x4*)(G + off + bj * 128);
          float r[8];
          r[0] = lo_bf(g[0]) * v0[0]; r[1] = hi_bf(g[0]) * v0[1]; r[2] = lo_bf(g[1]) * v0[2]; r[3] = hi_bf(g[1]) * v0[3];
          r[4] = lo_bf(g[2]) * v1[0]; r[5] = hi_bf(g[2]) * v1[1]; r[6] = lo_bf(g[3]) * v1[2]; r[7] = hi_bf(g[3]) * v1[3];
          if (ADD) { const u32x4 p = *(const u32x4*)(O + off + bj * 128);
            r[0] += lo_bf(p[0]); r[1] += hi_bf(p[0]); r[2] += lo_bf(p[1]); r[3] += hi_bf(p[1]);
            r[4] += lo_bf(p[2]); r[5] += hi_bf(p[2]); r[6] += lo_bf(p[3]); r[7] += hi_bf(p[3]); }
          u32x4 o; o[0] = cvt_pk_bf16(r[0], r[1]); o[1] = cvt_pk_bf16(r[2], r[3]); o[2] = cvt_pk_bf16(r[4], r[5]); o[3] = cvt_pk_bf16(r[6], r[7]);
          *(u32x4*)(O + off + bj * 128) = o; } }
  }
};
struct EpiRes {
  static constexpr bool PERM = false;
  const float* x0; const float* x1; float* OUT; const float* gate;
  __device__ __forceinline__ void operator()(const AccT& acc, const Unit& u, int wr, int wc, int fr, int fq) const {
    const int rowt = u.pm * 256; const int mi = mod_index(rowt);
    const int row0 = rowt + wr * 64 + fr, col0 = u.pn * 256 + wc * 32 + 4 * fq;
    const float* gp = gate + (size_t)mi * 6144 + col0;
    f32x4 gv[2][2];
#pragma unroll
    for (int bj = 0; bj < 2; ++bj)
#pragma unroll
      for (int n = 0; n < 2; ++n) gv[bj][n] = *(const f32x4*)(gp + bj * 128 + n * 16);
#pragma unroll
    for (int ai = 0; ai < 2; ++ai)
#pragma unroll
      for (int m = 0; m < 4; ++m) { const int row = row0 + ai * 128 + m * 16;
        const float* xr = x0 ? ((row < NCTX) ? x0 + (size_t)row * DM : x1 + (size_t)(row - NCTX) * DM) : OUT + (size_t)row * DM;
        float* orow = OUT + (size_t)row * DM;
#pragma unroll
        for (int bj = 0; bj < 2; ++bj)
#pragma unroll
          for (int n = 0; n < 2; ++n) { const int c = col0 + bj * 128 + n * 16;
            const f32x4 xv = *(const f32x4*)(xr + c);
            *(f32x4*)(orow + c) = xv + gv[bj][n] * acc[ai][bj][m][n]; } }
  }
};
template <bool FROMX> struct EpiResB {
  static constexpr bool PERM = true;
  const float* x0; const float* x1; const bf16_t* XI; bf16_t* XO; const float* gate; int row_base;
  __device__ __forceinline__ void operator()(const AccT& acc, const Unit& u, int wr, int wc, int fr, int fq) const {
    const int rowt = row_base + u.pm * 256; const int mi = mod_index(rowt);
    const int row0 = rowt + wr * 64 + fr, col0 = u.pn * 256 + wc * 32 + 8 * fq;
    const float* gp = gate + (size_t)mi * 6144 + col0;
    f32x4 gv[2][2];
#pragma unroll
    for (int bj = 0; bj < 2; ++bj)
#pragma unroll
      for (int n = 0; n < 2; ++n) gv[bj][n] = *(const f32x4*)(gp + bj * 128 + 4 * n);
#pragma unroll
    for (int ai = 0; ai < 2; ++ai)
#pragma unroll
      for (int m = 0; m < 4; ++m) { const int row = row0 + ai * 128 + m * 16;
        const float* xr = FROMX ? ((row < NCTX) ? x0 + (size_t)row * DM : x1 + (size_t)(row - NCTX) * DM) : nullptr;
#pragma unroll
        for (int bj = 0; bj < 2; ++bj) { const int c = col0 + bj * 128;
          f32x4 xa, xb;
          if (FROMX) { xa = *(const f32x4*)(xr + c); xb = *(const f32x4*)(xr + c + 4); }
          else { const u32x4 pv = *(const u32x4*)(XI + (size_t)row * DM + c); xa = (f32x4){lo_bf(pv[0]), hi_bf(pv[0]), lo_bf(pv[1]), hi_bf(pv[1])}; xb = (f32x4){lo_bf(pv[2]), hi_bf(pv[2]), lo_bf(pv[3]), hi_bf(pv[3])}; }
          const f32x4 oa = xa + gv[bj][0] * acc[ai][bj][m][0], ob = xb + gv[bj][1] * acc[ai][bj][m][1];
          u32x4 o; o[0] = cvt_pk_bf16(oa[0], oa[1]); o[1] = cvt_pk_bf16(oa[2], oa[3]); o[2] = cvt_pk_bf16(ob[0], ob[1]); o[3] = cvt_pk_bf16(ob[2], ob[3]);
          *(u32x4*)(XO + (size_t)row * DM + c) = o; } }
  }
};
struct EpiFf2Split {
  static constexpr bool PERM = true;
  const bf16_t* XI; bf16_t* XO; const float* gate; bf16_t* PART; int row_base;
  __device__ __forceinline__ void operator()(const AccT& acc, const Unit& u, int wr, int wc, int fr, int fq) const {
    const int rowl0 = u.pm * 256 + wr * 64 + fr, col0 = u.pn * 256 + wc * 32 + 8 * fq;
    if (u.ks == 0) {
      const float* gp = gate + (size_t)mod_index(row_base + u.pm * 256) * 6144 + col0;
      f32x4 gv[2][2];
#pragma unroll
      for (int bj = 0; bj < 2; ++bj)
#pragma unroll
        for (int n = 0; n < 2; ++n) gv[bj][n] = *(const f32x4*)(gp + bj * 128 + 4 * n);
#pragma unroll
      for (int ai = 0; ai < 2; ++ai)
#pragma unroll
        for (int m = 0; m < 4; ++m) { const size_t ro = (size_t)(row_base + rowl0 + ai * 128 + m * 16) * DM;
#pragma unroll
          for (int bj = 0; bj < 2; ++bj) { const int c = col0 + bj * 128; const u32x4 pv = *(const u32x4*)(XI + ro + c);
            const f32x4 xa = {lo_bf(pv[0]), hi_bf(pv[0]), lo_bf(pv[1]), hi_bf(pv[1])}, xb = {lo_bf(pv[2]), hi_bf(pv[2]), lo_bf(pv[3]), hi_bf(pv[3])};
            const f32x4 oa = xa + gv[bj][0] * acc[ai][bj][m][0], ob = xb + gv[bj][1] * acc[ai][bj][m][1];
            u32x4 o; o[0] = cvt_pk_bf16(oa[0], oa[1]); o[1] = cvt_pk_bf16(oa[2], oa[3]); o[2] = cvt_pk_bf16(ob[0], ob[1]); o[3] = cvt_pk_bf16(ob[2], ob[3]);
            *(u32x4*)(XO + ro + c) = o; } }
    } else {
#pragma unroll
      for (int ai = 0; ai < 2; ++ai)
#pragma unroll
        for (int m = 0; m < 4; ++m) { bf16_t* prow = PART + (size_t)(rowl0 + ai * 128 + m * 16) * DM;
#pragma unroll
          for (int bj = 0; bj < 2; ++bj) { const f32x4 v0 = acc[ai][bj][m][0], v1 = acc[ai][bj][m][1];
            u32x4 o; o[0] = cvt_pk_bf16(v0[0], v0[1]); o[1] = cvt_pk_bf16(v0[2], v0[3]); o[2] = cvt_pk_bf16(v1[0], v1[1]); o[3] = cvt_pk_bf16(v1[2], v1[3]);
            *(u32x4*)(prow + col0 + bj * 128) = o; } }
    }
  }
};
struct EpiFf1 {
  static constexpr bool PERM = true;
  bf16_t* H;
  __device__ __forceinline__ void operator()(const AccT& acc, const Unit& u, int wr, int wc, int fr, int fq) const {
    const int row0 = u.pm * 256 + wr * 64 + fr; const int col0 = u.pn * 256 + wc * 32 + 8 * fq;
    const __amdgpu_buffer_rsrc_t rs = wt_rsrc(H);
#pragma unroll
    for (int ai = 0; ai < 2; ++ai)
#pragma unroll
      for (int m = 0; m < 4; ++m) { bf16_t* rowp = H + (size_t)(row0 + ai * 128 + m * 16) * 4096 + col0;
#pragma unroll
        for (int bj = 0; bj < 2; ++bj) { f32x4 v0 = acc[ai][bj][m][0], v1 = acc[ai][bj][m][1];
#pragma unroll
          for (int j = 0; j < 4; ++j) { const float a = fmaxf(v0[j], 0.f), b = fmaxf(v1[j], 0.f); v0[j] = a * a; v1[j] = b * b; }
          u32x4 o; o[0] = cvt_pk_bf16(v0[0], v0[1]); o[1] = cvt_pk_bf16(v0[2], v0[3]); o[2] = cvt_pk_bf16(v1[0], v1[1]); o[3] = cvt_pk_bf16(v1[2], v1[3]);
          st16_wt(rs, H, rowp + bj * 128, o); } }
  }
};

__device__ __forceinline__ int win_col(int o) {
  if (o < 3072) return o;
  if (o < 4096) return 3456 + (o - 3072);
  if (o < 6144) { const int t = (o - 4096) >> 8, l = (o - 4096) & 255;
    const int bj = l >> 7, wc = (l >> 5) & 3, fq = (l >> 3) & 3, n = (l >> 2) & 1, j = l & 3;
    return (n ? 5504 : 4480) + t * 128 + bj * 64 + wc * 16 + fq * 4 + j; }
  if (o < 6656) { const int l = o - 6144; return l < 384 ? 3072 + l : -1; }
  return 6528 + (o - 6656);
}
template <bool WIN>
__device__ void transpose_job(LAS float* tile, const float* src, int srcN, bf16_t* dst, int O, int K) {
  const int tid = opaque_tid(), nkt = K / 64, ntiles = (O / 64) * nkt;
  for (int tI = blockIdx.x; tI < ntiles; tI += gridDim.x) {
    const int o0 = (tI / nkt) * 64, k0 = (tI % nkt) * 64;
    { const int tx = (tid & 15) * 4, ty = tid >> 4; const int o = o0 + tx; const int c = WIN ? win_col(o) : o;
#pragma unroll
      for (int i = 0; i < 2; ++i) { const int kl = ty + 32 * i; const f32x4 v = (c >= 0) ? *(const f32x4*)(src + (size_t)(k0 + kl) * srcN + c) : (f32x4){0.f, 0.f, 0.f, 0.f};
        tile[kl * 65 + tx] = v[0]; tile[kl * 65 + tx + 1] = v[1]; tile[kl * 65 + tx + 2] = v[2]; tile[kl * 65 + tx + 3] = v[3]; } }
    __syncthreads();
    { const int oy = tid >> 3, kx = (tid & 7) * 8; float v[8];
#pragma unroll
      for (int i = 0; i < 8; ++i) v[i] = tile[(kx + i) * 65 + oy];
      u32x4 o; o[0] = cvt_pk_bf16(v[0], v[1]); o[1] = cvt_pk_bf16(v[2], v[3]); o[2] = cvt_pk_bf16(v[4], v[5]); o[3] = cvt_pk_bf16(v[6], v[7]);
      *(u32x4*)(dst + (size_t)(o0 + oy) * K + k0 + kx) = o; }
    __syncthreads();
  }
}

template <int MODE, bool SRC16 = false>
__device__ void norm_rows(const float* x0, const float* x1, const float* g, const float* mod, int sh_off, int sc_off, bf16_t* dst, float* fout, const bf16_t* src16 = nullptr) {
  const int tid_ = opaque_tid(); const int lane = tid_ & 63, gw = blockIdx.x * 8 + (tid_ >> 6), nw = gridDim.x * 8;
  f32x4 gv[4];
#pragma unroll
  for (int i = 0; i < 4; ++i) gv[i] = *(const f32x4*)(g + i * 256 + lane * 4);
  const int rpw = (NT + gridDim.x - 1) / gridDim.x, rpv = (rpw + 7) / 8;
  const int rbeg = blockIdx.x * rpw + (tid_ >> 6) * rpv, rend = min(min(rbeg + rpv, (int)(blockIdx.x + 1) * rpw), NT);
  int cmi = -1; f32x4 scv[4], shv[4];
#pragma unroll
  for (int i = 0; i < 4; ++i) { scv[i] = (f32x4){0.f, 0.f, 0.f, 0.f}; shv[i] = (f32x4){0.f, 0.f, 0.f, 0.f}; }
  for (int row = rbeg; row < rend; row += 2) {
    const int rowb = (row + 1 < rend) ? (row + 1) : row;
    const float* xa = (row < NCTX) ? x0 + (size_t)row * DM : x1 + (size_t)(row - NCTX) * DM;
    const float* xb = (rowb < NCTX) ? x0 + (size_t)rowb * DM : x1 + (size_t)(rowb - NCTX) * DM;
    f32x4 va[4], vb[4]; float sa = 0.f, sb = 0.f;
    if (SRC16) {
#pragma unroll
      for (int i = 0; i < 4; ++i) { const u32x2 pa = *(const u32x2*)(src16 + (size_t)row * DM + i * 256 + lane * 4), pb = *(const u32x2*)(src16 + (size_t)rowb * DM + i * 256 + lane * 4);
        va[i] = (f32x4){lo_bf(pa[0]), hi_bf(pa[0]), lo_bf(pa[1]), hi_bf(pa[1])}; vb[i] = (f32x4){lo_bf(pb[0]), hi_bf(pb[0]), lo_bf(pb[1]), hi_bf(pb[1])}; }
    } else {
#pragma unroll
      for (int i = 0; i < 4; ++i) { va[i] = *(const f32x4*)(xa + i * 256 + lane * 4); vb[i] = *(const f32x4*)(xb + i * 256 + lane * 4); }
    }
    if (MODE == 1) {
      if (row >= 16384) { const float* gp = mod + (size_t)mod_index(row) * 6144 + sh_off; const bf16_t* pp = dst + (size_t)(row - 16384) * DM;
#pragma unroll
        for (int i = 0; i < 4; ++i) { const int cc = i * 256 + lane * 4; const u32x2 pv = *(const u32x2*)(pp + cc); const f32x4 gt = *(const f32x4*)(gp + cc);
          va[i][0] += gt[0] * lo_bf(pv[0]); va[i][1] += gt[1] * hi_bf(pv[0]); va[i][2] += gt[2] * lo_bf(pv[1]); va[i][3] += gt[3] * hi_bf(pv[1]); } }
      if (rowb >= 16384) { const float* gp = mod + (size_t)mod_index(rowb) * 6144 + sh_off; const bf16_t* pp = dst + (size_t)(rowb - 16384) * DM;
#pragma unroll
        for (int i = 0; i < 4; ++i) { const int cc = i * 256 + lane * 4; const u32x2 pv = *(const u32x2*)(pp + cc); const f32x4 gt = *(const f32x4*)(gp + cc);
          vb[i][0] += gt[0] * lo_bf(pv[0]); vb[i][1] += gt[1] * hi_bf(pv[0]); vb[i][2] += gt[2] * lo_bf(pv[1]); vb[i][3] += gt[3] * hi_bf(pv[1]); } }
    }
#pragma unroll
    for (int i = 0; i < 4; ++i) { sa += va[i][0] * va[i][0] + va[i][1] * va[i][1] + va[i][2] * va[i][2] + va[i][3] * va[i][3];
                                  sb += vb[i][0] * vb[i][0] + vb[i][1] * vb[i][1] + vb[i][2] * vb[i][2] + vb[i][3] * vb[i][3]; }
    sa = wave_sum(sa); sb = wave_sum(sb);
    const float ra = rsqrtf(sa * (1.0f / 1024.0f) + 1e-6f), rb = rsqrtf(sb * (1.0f / 1024.0f) + 1e-6f);
    if (MODE == 0) {
      const int mia = mod_index(row), mib = mod_index(rowb);
      if (mia != cmi) { cmi = mia; const float* ma = mod + (size_t)mia * 6144;
#pragma unroll
        for (int i = 0; i < 4; ++i) { scv[i] = *(const f32x4*)(ma + sc_off + i * 256 + lane * 4) + 1.0f; shv[i] = *(const f32x4*)(ma + sh_off + i * 256 + lane * 4); } }
      f32x4 scb[4], shb[4];
#pragma unroll
      for (int i = 0; i < 4; ++i) { scb[i] = scv[i]; shb[i] = shv[i]; }
      if (mib != mia) { const float* mb = mod + (size_t)mib * 6144;
#pragma unroll
        for (int i = 0; i < 4; ++i) { scb[i] = *(const f32x4*)(mb + sc_off + i * 256 + lane * 4) + 1.0f; shb[i] = *(const f32x4*)(mb + sh_off + i * 256 + lane * 4); } }
#pragma unroll
      for (int i = 0; i < 4; ++i) { const int cc = i * 256 + lane * 4;
        const f32x4 oa = va[i] * ra * gv[i] * scv[i] + shv[i], ob = vb[i] * rb * gv[i] * scb[i] + shb[i];
        u32x2 pa, pb; pa[0] = cvt_pk_bf16(oa[0], oa[1]); pa[1] = cvt_pk_bf16(oa[2], oa[3]); pb[0] = cvt_pk_bf16(ob[0], ob[1]); pb[1] = cvt_pk_bf16(ob[2], ob[3]);
        *(u32x2*)(dst + (size_t)row * DM + cc) = pa; if (rowb != row) *(u32x2*)(dst + (size_t)rowb * DM + cc) = pb; }
    } else {
#pragma unroll
      for (int i = 0; i < 4; ++i) { const int cc = i * 256 + lane * 4;
        *(f32x4*)(fout + (size_t)row * DM + cc) = va[i] * ra * gv[i]; if (rowb != row) *(f32x4*)(fout + (size_t)rowb * DM + cc) = vb[i] * rb * gv[i]; }
    }
  }
}

__device__ __forceinline__ unsigned cvt_pk_bf16_p(float lo, float hi) { return cvt_pk_bf16(lo, hi); }
__device__ __forceinline__ float fsigmoid(float x) { return __builtin_amdgcn_rcpf(1.0f + __expf(-x)); }
constexpr int AVP = 136;
constexpr int KBP = 1040, VVP = 528;
constexpr int SC_AV = 0, SC_KB = 128 * AVP, SC_WW = SC_KB + 16 * KBP, SC_VV = SC_WW + 4096, SC_CC = SC_VV + 16 * VVP, SC_BUFB = SC_CC + 2048;
constexpr int SC_YB = 2 * SC_BUFB;
constexpr int GSP = 32 * AVP;
constexpr int SC_GS = SC_YB + 16640;
constexpr int SC_WT = SC_GS + 4 * GSP;
constexpr int SC_CT = SC_WT + 2 * 64 * 144;
constexpr int SC_END = SC_CT + 1280;
struct CSetP { u32x4 A0, A1, A2, A3; };
struct PLoad { bf16x8 a00, a01, a10, a11; u32x2 k[4], r[4]; };
template <int DIR>
__device__ void scan_unit(const Params& p, LAS unsigned char* lds, int h, int half, int tb0, int n0, const float* s0,
                          int tb1, int tbstride, int n1, int nseg1, float* so1, size_t sostride, bf16_t* ydst, bool bgconv) {
  constexpr int dir = DIR;
  const int tid = opaque_tid(), lane = tid & 63, wid = __builtin_amdgcn_readfirstlane(tid >> 6);
  const int c = lane & 15, q = lane >> 4;
  const int nch = n0 + n1 * nseg1;
#define SC_TB(g_) (((g_) < n0) ? (tb0 + (DIR ? (n0 - 1 - (g_)) : (g_)) * 64) \
                               : (tb1 + (((g_) - n0) / n1) * tbstride + (DIR ? (n1 - 1 - (((g_) - n0) % n1)) : (((g_) - n0) % n1)) * 64))
  if (wid < 2) {
    __builtin_amdgcn_s_setprio(3);
    const int rowl = wid * 16 + c, rg = half * 32 + rowl;
    f32x4 acc0, acc1, acc2, acc3;
    if (s0 && n0 > 0) { const float* sp = s0 + rg * 64 + 4 * q; acc0 = *(const f32x4*)(sp); acc1 = *(const f32x4*)(sp + 16); acc2 = *(const f32x4*)(sp + 32); acc3 = *(const f32x4*)(sp + 48); }
    else { acc0 = acc1 = acc2 = acc3 = (f32x4){0.f, 0.f, 0.f, 0.f}; }
    CSetP SA, SB;
    for (int ci = 0; ci < nch; ++ci) {
      __syncthreads();
      if (ci >= n0 && ci > 0 && ((ci - n0) % n1) == 0) acc0 = acc1 = acc2 = acc3 = (f32x4){0.f, 0.f, 0.f, 0.f};
      LAS unsigned char* B = lds + (ci & 1) * SC_BUFB;
      LAS float* yb = (LAS float*)(lds + SC_YB) + (ci & 1) * (32 * 65) + rowl * 65;
      LAS unsigned char* pA = B + SC_AV + (c & 3) * AVP + 8 * q;
      LAS unsigned char* pW = B + SC_WW + 16 * q;
      LAS unsigned char* pK = B + SC_KB + 16 * c;
      LAS unsigned char* pV = B + SC_VV + 16 * rowl;
      LAS unsigned char* pC = B + SC_CC;
      LAS unsigned char* pE = B + SC_CC + 512 + (c & 3) * 8;
      LAS unsigned char* pY = B + SC_CC + 1024 + (c & 3) * 16;
#define SC_RL(s_) (DIR ? (15 - (s_)) : (s_))
#define SC_LDP(o, rl_) do { const int _r = (rl_) * (8 * AVP); \
      { const u32x2 _x0 = *(const LAS u32x2*)(pA + _r), _x1 = *(const LAS u32x2*)(pA + _r + 32), _x2 = *(const LAS u32x2*)(pA + _r + 64), _x3 = *(const LAS u32x2*)(pA + _r + 96); \
        const u32x2 _x4 = *(const LAS u32x2*)(pA + _r + 4 * AVP), _x5 = *(const LAS u32x2*)(pA + _r + 4 * AVP + 32), _x6 = *(const LAS u32x2*)(pA + _r + 4 * AVP + 64), _x7 = *(const LAS u32x2*)(pA + _r + 4 * AVP + 96); \
        o.A0[0] = _x0[0]; o.A0[1] = _x0[1]; o.A0[2] = _x1[0]; o.A0[3] = _x1[1]; o.A1[0] = _x2[0]; o.A1[1] = _x2[1]; o.A1[2] = _x3[0]; o.A1[3] = _x3[1]; \
        o.A2[0] = _x4[0]; o.A2[1] = _x4[1]; o.A2[2] = _x5[0]; o.A2[3] = _x5[1]; o.A3[0] = _x6[0]; o.A3[1] = _x6[1]; o.A3[2] = _x7[0]; o.A3[3] = _x7[1]; } } while (0)
#define SC_ROUND(C, N, ri_, rnx_) do { const int _rl = SC_RL(ri_); \
      SC_LDP(N, SC_RL(rnx_)); \
      const u32x4 K0 = *(const LAS u32x4*)(pK + _rl * KBP), K1 = *(const LAS u32x4*)(pK + _rl * KBP + 256), K2 = *(const LAS u32x4*)(pK + _rl * KBP + 512), K3 = *(const LAS u32x4*)(pK + _rl * KBP + 768); \
      const f32x4 vv = *(const LAS f32x4*)(pV + _rl * VVP); \
      const f32x4 e2a = *(const LAS f32x4*)(pC + _rl * 32), e2b = *(const LAS f32x4*)(pC + _rl * 32 + 16); \
      const u32x2 eva = *(const LAS u32x2*)(pE + _rl * 32); const u32x4 evy = *(const LAS u32x4*)(pY + _rl * 64); \
      asm volatile("" ::: "memory"); \
        \
      u32x4 b0, b1; \
      b0[0] = cvt_pk_bf16_p(acc0[0], acc0[1]); b0[1] = cvt_pk_bf16_p(acc0[2], acc0[3]); b0[2] = cvt_pk_bf16_p(acc1[0], acc1[1]); b0[3] = cvt_pk_bf16_p(acc1[2], acc1[3]); \
      const f32x4 zz = {0.f, 0.f, 0.f, 0.f}; \
      f32x4 dA = __builtin_amdgcn_mfma_f32_16x16x32_bf16(__builtin_bit_cast(bf16x8, C.A0), __builtin_bit_cast(bf16x8, b0), zz, 0, 0, 0); \
      f32x4 dB = __builtin_amdgcn_mfma_f32_16x16x32_bf16(__builtin_bit_cast(bf16x8, C.A2), __builtin_bit_cast(bf16x8, b0), zz, 0, 0, 0); \
      b1[0] = cvt_pk_bf16_p(acc2[0], acc2[1]); b1[1] = cvt_pk_bf16_p(acc2[2], acc2[3]); b1[2] = cvt_pk_bf16_p(acc3[0], acc3[1]); b1[3] = cvt_pk_bf16_p(acc3[2], acc3[3]); \
      dA = __builtin_amdgcn_mfma_f32_16x16x32_bf16(__builtin_bit_cast(bf16x8, C.A1), __builtin_bit_cast(bf16x8, b1), dA, 0, 0, 0); \
      dB = __builtin_amdgcn_mfma_f32_16x16x32_bf16(__builtin_bit_cast(bf16x8, C.A3), __builtin_bit_cast(bf16x8, b1), dB, 0, 0, 0); \
      const float v1 = vv[0], v2 = vv[1], v3 = vv[2], v4 = vv[3]; \
      { const unsigned be0 = cvt_pk_bf16_p(v1, v2), be1 = cvt_pk_bf16_p(v3, v4); \
        const u32x4 bev = {(q == 0) ? be0 : 0u, (q == 0) ? be1 : 0u, 0u, 0u}; const u32x4 ae0 = {eva[0], eva[1], 0u, 0u}; \
          \
        dA = __builtin_amdgcn_mfma_f32_16x16x32_bf16(__builtin_bit_cast(bf16x8, ae0), __builtin_bit_cast(bf16x8, bev), dA, 0, 0, 0); } \
      const float psa1 = dA[0]; \
      const float psa2 = dA[1] + psa1 * e2a[0];     \
      const float psa3 = dA[2] + psa1 * e2a[1] + psa2 * e2a[2]; \
      const float psa4 = dA[3] + psa1 * e2a[3] + psa2 * e2b[0] + psa3 * e2b[1]; \
      u32x4 bbv; \
      { const unsigned bd1 = cvt_pk_bf16_p(v1, psa1), bd2 = cvt_pk_bf16_p(v2, psa2), bd3 = cvt_pk_bf16_p(v3, psa3), bd4 = cvt_pk_bf16_p(v4, psa4);     \
        bbv[0] = (q == 0) ? bd1 : 0u; bbv[1] = (q == 0) ? bd2 : 0u; bbv[2] = (q == 0) ? bd3 : 0u; bbv[3] = (q == 0) ? bd4 : 0u; } \
      const bf16x8 bb = __builtin_bit_cast(bf16x8, bbv); \
        \
      dB = __builtin_amdgcn_mfma_f32_16x16x32_bf16(__builtin_bit_cast(bf16x8, evy), bb, dB, 0, 0, 0); \
      acc0 = __builtin_amdgcn_mfma_f32_16x16x32_bf16(__builtin_bit_cast(bf16x8, K0), bb, acc0, 0, 0, 0); \
      acc1 = __builtin_amdgcn_mfma_f32_16x16x32_bf16(__builtin_bit_cast(bf16x8, K1), bb, acc1, 0, 0, 0); \
      acc2 = __builtin_amdgcn_mfma_f32_16x16x32_bf16(__builtin_bit_cast(bf16x8, K2), bb, acc2, 0, 0, 0); \
      acc3 = __builtin_amdgcn_mfma_f32_16x16x32_bf16(__builtin_bit_cast(bf16x8, K3), bb, acc3, 0, 0, 0); \
      { const float ya = (q & 1) ? dB[1] : dB[0], ybv = (q & 1) ? dB[3] : dB[2]; yb[DIR ? (4 * _rl + 3 - q) : (4 * _rl + q)] = (q & 2) ? ybv : ya; } \
      asm volatile("" ::: "memory"); __builtin_amdgcn_sched_barrier(0); } while (0)
      SC_LDP(SA, SC_RL(0));
      for (int g = 0; g < 8; ++g) {
        const int r0 = g * 2; const int rlast = (r0 + 2 < 16) ? (r0 + 2) : 15;
        f32x4 wt0, wt1, wt2, wt3;
        if (g & 1) { const int tl = SC_RL(r0) >> 2;
          wt0 = *(const LAS f32x4*)(pW + tl * 256); wt1 = *(const LAS f32x4*)(pW + tl * 256 + 64); wt2 = *(const LAS f32x4*)(pW + tl * 256 + 128); wt3 = *(const LAS f32x4*)(pW + tl * 256 + 192); }
        SC_ROUND(SA, SB, r0, r0 + 1);
        SC_ROUND(SB, SA, r0 + 1, rlast);
        if (g & 1) { acc0 *= wt0; acc1 *= wt1; acc2 *= wt2; acc3 *= wt3; }
      }
      if (ci >= n0 && ((ci - n0) % n1) == n1 - 1) {
        float* sp = so1 + (size_t)((ci - n0) / n1) * sostride + rg * 64 + 4 * q; *(f32x4*)(sp) = acc0; *(f32x4*)(sp + 16) = acc1; *(f32x4*)(sp + 32) = acc2; *(f32x4*)(sp + 48) = acc3; }
    }
    __syncthreads();
    __builtin_amdgcn_s_setprio(0);
#undef SC_LDP
#undef SC_ROUND
#undef SC_RL
  } else if (wid == 4 || wid == 5) {
    const int L = (wid - 4) * 64 + lane, ft = L >> 1, rh = L & 1;
    const bf16_t* Uq = (const bf16_t*)(p.ws + WS_U); bf16_t* CBq = (bf16_t*)(p.ws + WS_CB);
    float cw0[8], cw1[8], cw2[8];
    if (bgconv) {
#pragma unroll
      for (int i = 0; i < 8; ++i) { cw0[i] = p.in[21][L * 8 + i]; cw1[i] = p.in[21][1024 + L * 8 + i]; cw2[i] = p.in[21][2048 + L * 8 + i]; } }
    LAS float* tsc = (LAS float*)(lds + SC_TT) + (wid - 4) * 1056;
    const bf16_t* Vq = (const bf16_t*)(p.ws + WS_V);
#define FL_VVFILL(g_) do { const int _tb = SC_TB(g_); LAS unsigned char* _B = lds + ((g_) & 1) * SC_BUFB; const int _tl = L >> 1, _rh = L & 1; \
      const bf16_t* _vp = Vq + (size_t)(_tb + _tl) * DM + h * 64 + half * 32 + _rh * 16; const u32x4 _v0 = *(const u32x4*)(_vp), _v1 = *(const u32x4*)(_vp + 8); \
      const int _js = DIR ? (3 - (_tl & 3)) : (_tl & 3); LAS unsigned char* _wp = _B + SC_VV + (_tl >> 2) * VVP + ((_rh * 16) * 4 + _js) * 4; \
      _Pragma("unroll") for (int i = 0; i < 4; ++i) { *(LAS float*)(_wp + (2 * i) * 16) = lo_bf(_v0[i]); *(LAS float*)(_wp + (2 * i + 1) * 16) = hi_bf(_v0[i]); \
        *(LAS float*)(_wp + (8 + 2 * i) * 16) = lo_bf(_v1[i]); *(LAS float*)(_wp + (8 + 2 * i + 1) * 16) = hi_bf(_v1[i]); } } while (0)
    if (nch > 0) FL_VVFILL(0);
    for (int ci = 0; ci <= nch; ++ci) {
      __syncthreads();
      if (ci + 1 < nch) FL_VVFILL(ci + 1);
#define BG_TRANSPOSE(src_, srcN_, dst_, Kd_, jt_) do { const int _nkt = (Kd_) / 32; const int _o0 = ((jt_) / _nkt) * 32, _k0 = ((jt_) % _nkt) * 32; \
        { const int kr = lane >> 3, oc = (lane & 7) * 4; \
          _Pragma("unroll") for (int pz = 0; pz < 4; ++pz) { const f32x4 v = *(const f32x4*)((src_) + (size_t)(_k0 + kr + 8 * pz) * (srcN_) + _o0 + oc); \
            LAS float* tp = tsc + (kr + 8 * pz) * 33 + oc; tp[0] = v[0]; tp[1] = v[1]; tp[2] = v[2]; tp[3] = v[3]; } } \
        { const int oo = lane & 31, kh = lane >> 5; float w[16]; \
          _Pragma("unroll") for (int i = 0; i < 16; ++i) w[i] = tsc[(kh * 16 + i) * 33 + oo]; \
          u32x4 a, b2; \
          _Pragma("unroll") for (int i = 0; i < 4; ++i) { a[i] = cvt_pk_bf16(w[2 * i], w[2 * i + 1]); b2[i] = cvt_pk_bf16(w[8 + 2 * i], w[8 + 2 * i + 1]); } \
          bf16_t* dp = (dst_) + (size_t)(_o0 + oo) * (Kd_) + _k0 + kh * 16; *(u32x4*)(dp) = a; *(u32x4*)(dp + 8) = b2; } } while (0)
      if (bgconv && ci < 80 && (ci % 5) == 0) {
        const int job = (blockIdx.x * 2 + (wid - 4)) * 16 + ci / 5;
        const bool second = job >= 4096; const int jt = second ? job - 4096 : job;
        const float* src = second ? p.in[26] : p.in[25]; const int srcN = second ? 1024 : 4096, Kd = second ? 4096 : 1024;
        bf16_t* dstw = (bf16_t*)(p.ws + (second ? WS_WFF2 : WS_WFF1));
        BG_TRANSPOSE(src, srcN, dstw, Kd, jt);
      }
      if (bgconv && ci < 35 && (ci % 5) == 2) {
        const int job = (blockIdx.x * 2 + (wid - 4)) * 7 + ci / 5;
        if (job < 3072) { const int which = job >> 10, jt = job & 1023;
          const float* src = (which == 0) ? p.in[22] : (which == 1) ? p.in[23] : p.in[24];
          bf16_t* dstw = (bf16_t*)(p.ws + WS_WPA) + (size_t)which * 1024 * 1024;
          BG_TRANSPOSE(src, 1024, dstw, 1024, jt);
        } else if (job < 3200) { const int jt = job - 3072;
          BG_TRANSPOSE(p.in[15], 1024, (bf16_t*)(p.ws + WS_G2T), 128, jt); }
      }
#undef BG_TRANSPOSE
      if (bgconv && ci < 80) {
        const int tok = blockIdx.x * 80 + ci; const int Wm = (tok < NCTX) ? 255 : 63; const int pos = tok & Wm;
        const size_t off = (size_t)tok * DM + L * 8;
        const u32x4 uc = *(const u32x4*)(Uq + off), cbv = *(const u32x4*)(CBq + off);
        u32x4 up = {0u, 0u, 0u, 0u}, un = {0u, 0u, 0u, 0u};
        if (pos != 0) up = *(const u32x4*)(Uq + off - DM);
        if (pos != Wm) un = *(const u32x4*)(Uq + off + DM);
        float o[8];
#pragma unroll
        for (int i = 0; i < 4; ++i) {
          o[2 * i] = lo_bf(cbv[i]) * (cw0[2 * i] * lo_bf(up[i]) + cw1[2 * i] * lo_bf(uc[i]) + cw2[2 * i] * lo_bf(un[i]));
          o[2 * i + 1] = hi_bf(cbv[i]) * (cw0[2 * i + 1] * hi_bf(up[i]) + cw1[2 * i + 1] * hi_bf(uc[i]) + cw2[2 * i + 1] * hi_bf(un[i]));
        }
        u32x4 ob; ob[0] = cvt_pk_bf16(o[0], o[1]); ob[1] = cvt_pk_bf16(o[2], o[3]); ob[2] = cvt_pk_bf16(o[4], o[5]); ob[3] = cvt_pk_bf16(o[6], o[7]);
        *(u32x4*)(CBq + off) = ob;
      }
      if (ci >= 1) {
        const int cj = ci - 1, tb = SC_TB(cj);
        const LAS float* yb = (const LAS float*)(lds + SC_YB) + (cj & 1) * (32 * 65) + (rh * 16) * 65 + ft;
        float yv[16];
#pragma unroll
        for (int i = 0; i < 16; ++i) yv[i] = yb[i * 65];
        u32x4 o0, o1;
#pragma unroll
        for (int i = 0; i < 4; ++i) { o0[i] = cvt_pk_bf16(yv[2 * i], yv[2 * i + 1]); o1[i] = cvt_pk_bf16(yv[8 + 2 * i], yv[8 + 2 * i + 1]); }
        bf16_t* dp = ydst + (size_t)(tb + ft) * DM + h * 64 + half * 32 + rh * 16;
        *(u32x4*)(dp) = o0; *(u32x4*)(dp + 8) = o1;
      }
    }
  } else {
    const int pw = (wid & 1) + ((wid >> 2) << 1), t0 = pw * 16;
    const bf16_t* Rr = (const bf16_t*)(p.ws + WS_R); const bf16_t* Kr = (const bf16_t*)(p.ws + WS_K); const bf16_t* Vr = (const bf16_t*)(p.ws + WS_V);
    const bf16_t* LOR = (const bf16_t*)(p.ws + WS_LOR);
    float* C3 = (float*)(p.ws + WS_C3);
    LAS float* CT = (LAS float*)(lds + SC_CT);
    LAS unsigned char* WT = lds + SC_WT;
    LAS unsigned char* GS = lds + SC_GS + pw * GSP;
    { const int ch = h * 64 + lane;
      CT[lane] = p.in[11][dir * 1024 + ch]; CT[64 + lane] = p.in[13][dir * 1024 + ch]; CT[128 + lane] = p.in[16][ch]; CT[192 + lane] = p.in[17][ch]; CT[256 + lane] = p.in[18][ch];
#pragma unroll 2
      for (int i = 0; i < 16; ++i) { const int e = i * 64 + lane; const int sel = e >> 9, row = (e >> 3) & 63, seg = e & 7;
        const u32x4 wv = *(const u32x4*)((const bf16_t*)(p.ws + (sel ? WS_A2T : WS_W2T)) + ((size_t)(dir * 1024 + h * 64 + row)) * 64 + seg * 8);
        *(LAS u32x4*)(WT + (sel * 64 + row) * 144 + seg * 16) = wv; } }
    const int js = DIR ? (3 - (c & 3)) : (c & 3);
#define SC_PLD_A(o, ci_) do { const size_t _tok = (size_t)(SC_TB(ci_) + t0 + c); \
      const bf16_t* _ap = LOR + _tok * 384 + dir * 64 + q * 8; \
      o.a00 = *(const bf16x8*)(_ap); o.a01 = *(const bf16x8*)(_ap + 32); o.a10 = *(const bf16x8*)(_ap + 128); o.a11 = *(const bf16x8*)(_ap + 160); } while (0)
#define SC_PLD_K(o, ci_) do { const size_t _tok = (size_t)(SC_TB(ci_) + t0 + c); \
      const size_t _to = _tok * DM + h * 64; \
      _Pragma("unroll") for (int nt = 0; nt < 4; ++nt) { o.k[nt] = *(const u32x2*)(Kr + _to + nt * 16 + 4 * q); o.r[nt] = *(const u32x2*)(Rr + _to + nt * 16 + 4 * q); } } while (0)
    PLoad cur; SC_PLD_A(cur, 0); SC_PLD_K(cur, 0);
    for (int ci = 0; ci < nch; ++ci) {
      const int tb = SC_TB(ci);
      LAS unsigned char* B = lds + (ci & 1) * SC_BUFB;
      const int cn = (ci + 1 < nch) ? (ci + 1) : ci;
      const int t = t0 + c, rho = t >> 2;
      float ss = 0.f, c1 = 0.f, c2 = 0.f, c3 = 0.f;
      f32x4 decr[4], avr[4], kkr4[4], kdr4[4], rfr4[4];
#pragma unroll
      for (int nt = 0; nt < 4; ++nt) {
        const bf16x8 w0f = *(const LAS bf16x8*)(WT + (nt * 16 + c) * 144 + q * 16), w1f = *(const LAS bf16x8*)(WT + (nt * 16 + c) * 144 + 64 + q * 16);
        const bf16x8 a0f = *(const LAS bf16x8*)(WT + (64 + nt * 16 + c) * 144 + q * 16), a1f = *(const LAS bf16x8*)(WT + (64 + nt * 16 + c) * 144 + 64 + q * 16);
        f32x4 X = {0.f, 0.f, 0.f, 0.f}, Y = {0.f, 0.f, 0.f, 0.f};
        X = __builtin_amdgcn_mfma_f32_16x16x32_bf16(w0f, cur.a00, X, 0, 0, 0); X = __builtin_amdgcn_mfma_f32_16x16x32_bf16(w1f, cur.a01, X, 0, 0, 0);
        Y = __builtin_amdgcn_mfma_f32_16x16x32_bf16(a0f, cur.a10, Y, 0, 0, 0); Y = __builtin_amdgcn_mfma_f32_16x16x32_bf16(a1f, cur.a11, Y, 0, 0, 0);
        const int kb = nt * 16 + 4 * q;
        const f32x4 tw0 = *(const LAS f32x4*)(CT + kb), ta0 = *(const LAS f32x4*)(CT + 64 + kb), tkk = *(const LAS f32x4*)(CT + 128 + kb), tka = *(const LAS f32x4*)(CT + 192 + kb), trk = *(const LAS f32x4*)(CT + 256 + kb);
        const float kf[4] = {lo_bf(cur.k[nt][0]), hi_bf(cur.k[nt][0]), lo_bf(cur.k[nt][1]), hi_bf(cur.k[nt][1])};
        const float rf[4] = {lo_bf(cur.r[nt][0]), hi_bf(cur.r[nt][0]), lo_bf(cur.r[nt][1]), hi_bf(cur.r[nt][1])};
#pragma unroll
        for (int j = 0; j < 4; ++j) {
          decr[nt][j] = __expf(-0.6065306597126334f * fsigmoid(tw0[j] + X[j]));
          const float av = fsigmoid(ta0[j] + Y[j]); avr[nt][j] = av;
          const float kr_ = kf[j] * tkk[j]; ss += kr_ * kr_;
          const float kd = kf[j] * (1.0f + (av - 1.0f) * tka[j]);
          kkr4[nt][j] = kr_; kdr4[nt][j] = kd; rfr4[nt][j] = rf[j];
          c1 += kd * rf[j]; c3 += rf[j] * kd * trk[j];
        }
      }
      SC_PLD_A(cur, cn);
      ss += __shfl_xor(ss, 16); ss += __shfl_xor(ss, 32);
      const float inv = rsqrtf(fmaxf(ss, 1e-12f));
#pragma unroll
      for (int nt = 0; nt < 4; ++nt) {
        const int kb = nt * 16 + 4 * q;
        const f32x4 rf = rfr4[nt];
        float kkt[4], wrt[4], kdt[4], bt[4]; f32x4 pin;
#pragma unroll
        for (int j = 0; j < 4; ++j) {
          const float dec = decr[nt][j], av = avr[nt][j];
          const float kk = kkr4[nt][j] * inv, bv = -(kk * av), kd = kdr4[nt][j];
          c2 += bv * rf[j];
          float Pin = dec;
          Pin *= DIR ? dppo<0x101>(1.0f, Pin) : dppo<0x111>(1.0f, Pin);
          Pin *= DIR ? dppo<0x102>(1.0f, Pin) : dppo<0x112>(1.0f, Pin);
          Pin *= DIR ? dppo<0x104>(1.0f, Pin) : dppo<0x114>(1.0f, Pin);
          Pin *= DIR ? dppo<0x108>(1.0f, Pin) : dppo<0x118>(1.0f, Pin);
          const float Pex = DIR ? dppo<0x101>(1.0f, Pin) : dppo<0x111>(1.0f, Pin);
          const float rP = __builtin_amdgcn_rcpf(Pin);
          kkt[j] = kk * Pex; wrt[j] = rf[j] * Pin; kdt[j] = kd * rP; bt[j] = bv * rP; pin[j] = Pin;
          *(LAS unsigned*)(B + SC_KB + rho * KBP + ((kb + j) * 4 + js) * 4) = cvt_pk_bf16(kdt[j], bt[j]);
        }
        { u32x2 o; o[0] = cvt_pk_bf16(kkt[0], kkt[1]); o[1] = cvt_pk_bf16(kkt[2], kkt[3]); *(LAS u32x2*)(B + SC_AV + (rho * 8 + js) * AVP + kb * 2) = o; }
        { u32x2 o; o[0] = cvt_pk_bf16(wrt[0], wrt[1]); o[1] = cvt_pk_bf16(wrt[2], wrt[3]); *(LAS u32x2*)(B + SC_AV + (rho * 8 + 4 + js) * AVP + kb * 2) = o; }
        { u32x2 o; o[0] = cvt_pk_bf16(kdt[0], kdt[1]); o[1] = cvt_pk_bf16(kdt[2], kdt[3]); *(LAS u32x2*)(GS + (c * 2 + 0) * AVP + kb * 2) = o; }
        { u32x2 o; o[0] = cvt_pk_bf16(bt[0], bt[1]); o[1] = cvt_pk_bf16(bt[2], bt[3]); *(LAS u32x2*)(GS + (c * 2 + 1) * AVP + kb * 2) = o; }
        if ((DIR ? (15 - c) : c) == 15) *(LAS f32x4*)(B + SC_WW + (pw * 64 + kb) * 4) = pin;
      }
      c1 += __shfl_xor(c1, 16); c1 += __shfl_xor(c1, 32); c2 += __shfl_xor(c2, 16); c2 += __shfl_xor(c2, 32); c3 += __shfl_xor(c3, 16); c3 += __shfl_xor(c3, 32);
      LAS float* cp = (LAS float*)(B + SC_CC + rho * 32);
      LAS unsigned short* eva = (LAS unsigned short*)(B + SC_CC + 512 + rho * 32);
      LAS unsigned short* evy = (LAS unsigned short*)(B + SC_CC + 1024 + rho * 64);
      if (q == 0 && half == 0) C3[((size_t)dir * NT + tb + t) * 16 + h] = c3;
      { const LAS unsigned char* ap = B + SC_AV + (rho * 8 + js) * AVP + 16 * q;
        const LAS unsigned char* gp = GS + (c * 2) * AVP + 16 * q;
#define SC_LD16(p_) ({ const u32x2 _a = *(const LAS u32x2*)(p_), _b = *(const LAS u32x2*)((p_) + 8); const u32x4 _v = {_a[0], _a[1], _b[0], _b[1]}; __builtin_bit_cast(bf16x8, _v); })
        const bf16x8 akk0 = SC_LD16(ap), akk1 = SC_LD16(ap + 64), awr0 = SC_LD16(ap + 4 * AVP), awr1 = SC_LD16(ap + 4 * AVP + 64);
        const bf16x8 bkd0 = SC_LD16(gp), bkd1 = SC_LD16(gp + 64), bb0 = SC_LD16(gp + AVP), bb1 = SC_LD16(gp + AVP + 64);
#undef SC_LD16
        const f32x4 zz = {0.f, 0.f, 0.f, 0.f};
        f32x4 gE1 = __builtin_amdgcn_mfma_f32_16x16x32_bf16(akk0, bkd0, zz, 0, 0, 0); gE1 = __builtin_amdgcn_mfma_f32_16x16x32_bf16(akk1, bkd1, gE1, 0, 0, 0);
        f32x4 gE2 = __builtin_amdgcn_mfma_f32_16x16x32_bf16(akk0, bb0, zz, 0, 0, 0);  gE2 = __builtin_amdgcn_mfma_f32_16x16x32_bf16(akk1, bb1, gE2, 0, 0, 0);
        f32x4 gF1 = __builtin_amdgcn_mfma_f32_16x16x32_bf16(awr0, bkd0, zz, 0, 0, 0); gF1 = __builtin_amdgcn_mfma_f32_16x16x32_bf16(awr1, bkd1, gF1, 0, 0, 0);
        f32x4 gF2 = __builtin_amdgcn_mfma_f32_16x16x32_bf16(awr0, bb0, zz, 0, 0, 0);  gF2 = __builtin_amdgcn_mfma_f32_16x16x32_bf16(awr1, bb1, gF2, 0, 0, 0);
        if (q == (c >> 2)) {
#pragma unroll
          for (int jj = 0; jj < 4; ++jj) { const int jsj = DIR ? (3 - jj) : jj;
            const float eE = (jsj > js) ? gE1[jj] : 0.f;
            const float eFv = (jsj > js) ? gF1[jj] : ((jsj == js) ? c1 : 0.f);
            const float eFp = (jsj > js) ? gF2[jj] : ((jsj == js) ? c2 : 0.f);
            eva[jsj * 4 + js] = (unsigned short)(cvt_pk_bf16(eE, 0.f) & 0xffffu);
            *(LAS unsigned*)(evy + jsj * 8 + 2 * js) = cvt_pk_bf16(eFv, eFp);
            if (jsj > js) { const int idx = jsj * (jsj - 1) / 2 + js; cp[idx] = gE2[jj]; } }
        }
      }
      SC_PLD_K(cur, cn);
      __syncthreads();
    }
    __syncthreads();
#undef SC_PLD_A
#undef SC_PLD_K
  }
  __syncthreads();
#undef SC_TB
}

#define XB_TMO      128
#define XB_XCNT(j)  (256  + 64 * (j))
#define XB_XSUB(j)  (1280 + 64 * (j))
#define XB_XGEN(j)  (2304 + 64 * (j))
#define XB_TOP      3328
#define XB_TOPGEN   3392
#define XCD_BAR_WORDS 3456
#define XB_SPIN_CAP (1u << 18)
__device__ __forceinline__ unsigned xb_ld(unsigned* p)              { return __hip_atomic_load(p, __ATOMIC_RELAXED, __HIP_MEMORY_SCOPE_AGENT); }
__device__ __forceinline__ unsigned xb_add(unsigned* p, unsigned v) { return __hip_atomic_fetch_add(p, v, __ATOMIC_RELAXED, __HIP_MEMORY_SCOPE_AGENT); }
__device__ __forceinline__ unsigned xb_xcc_id() { return (unsigned)__builtin_amdgcn_s_getreg((3 << 11) | 20) & 0xFu; }
#define XB_SPIN(cond, bar) do { unsigned _sp = 0; while (cond) { __builtin_amdgcn_s_sleep(1); \
    if ((++_sp & 255u) == 0u) { if (xb_ld(&(bar)[XB_TMO])) break; if (_sp > XB_SPIN_CAP) { atomicAdd(&(bar)[XB_TMO], 1u); break; } } } } while (0)
struct XcdBarrier { unsigned* bar; unsigned x; volatile LAS unsigned* st; };
__device__ __forceinline__ XcdBarrier xcd_barrier_post(unsigned* bar, volatile LAS unsigned* st) {
  XcdBarrier b; b.bar = bar; b.x = xb_xcc_id(); b.st = st;
  if (threadIdx.x == 0) (void)xb_add(&bar[XB_XCNT(b.x)], 1u);
  return b;
}
__device__ __forceinline__ void xcd_barrier_complete(unsigned* bar, unsigned x, unsigned& nloc, unsigned& nx) {
  const unsigned G = gridDim.x * gridDim.y * gridDim.z;
  unsigned sum, cnt, mine, sp = 0u;
  for (;;) {
    sum = 0u; cnt = 0u; mine = 0u;
#pragma unroll
    for (unsigned j = 0; j < 16; ++j) { const unsigned c = xb_ld(&bar[XB_XCNT(j)]); sum += c; cnt += (c > 0u) ? 1u : 0u; mine = (j == x) ? c : mine; }
    if (sum == G) break;
    __builtin_amdgcn_s_sleep(1);
    if ((++sp & 255u) == 0u) { if (xb_ld(&bar[XB_TMO])) break; if (sp > XB_SPIN_CAP) { atomicAdd(&bar[XB_TMO], 1u); break; } }
  }
  nloc = mine > 0u ? mine : 1u; nx = cnt > 0u ? cnt : 1u;
}
__device__ __forceinline__ void xcd_barrier(const XcdBarrier& b) {
  asm volatile("s_waitcnt vmcnt(0)" ::: "memory");
  __syncthreads();
  if (threadIdx.x == 0) {
    unsigned* bar = b.bar;
    __builtin_amdgcn_s_waitcnt(0);
    unsigned nloc = b.st[0], nx = b.st[1];
    if (nloc == 0u) { xcd_barrier_complete(bar, b.x, nloc, nx); b.st[0] = nloc; b.st[1] = nx; }
    const unsigned old = xb_add(&bar[XB_XSUB(b.x)], 1u);
    const unsigned gen = old / nloc;
    if (old + 1u == (gen + 1u) * nloc) {
      __builtin_amdgcn_fence(__ATOMIC_RELEASE, "agent");
      asm volatile("s_waitcnt vmcnt(0)" ::: "memory");
      const unsigned og = xb_add(&bar[XB_TOP], 1u);
      const unsigned tg = og / nx;
      if (og + 1u == (tg + 1u) * nx) xb_add(&bar[XB_TOPGEN], 1u);
      else XB_SPIN(xb_ld(&bar[XB_TOPGEN]) == tg, bar);
      __builtin_amdgcn_fence(__ATOMIC_ACQUIRE, "agent");
      xb_add(&bar[XB_XGEN(b.x)], 1u);
      asm volatile("s_waitcnt vmcnt(0)" ::: "memory");
    } else {
      XB_SPIN(xb_ld(&bar[XB_XGEN(b.x)]) == gen, bar);
      __builtin_amdgcn_fence(__ATOMIC_ACQUIRE, "agent");
      asm volatile("s_waitcnt vmcnt(0)" ::: "memory");
    }
  }
  __syncthreads();
}

__global__ void __launch_bounds__(512, 2) mega(Params p) {
  extern __shared__ __attribute__((aligned(16))) unsigned char lds_raw[];
  LAS unsigned char* lds = (LAS unsigned char*)lds_raw;
  cg::grid_group grid = cg::this_grid();
  unsigned char* ws = p.ws;
  bf16_t* const rR = (bf16_t*)(ws + WS_R); bf16_t* const rK = (bf16_t*)(ws + WS_K); bf16_t* const rCB = (bf16_t*)(ws + WS_CB);
  bf16_t* const rU = (bf16_t*)(ws + WS_U); bf16_t* const rV = (bf16_t*)(ws + WS_V); bf16_t* const rLOR = (bf16_t*)(ws + WS_LOR);
  bf16_t* const D0 = (bf16_t*)p.out; bf16_t* const D1 = (bf16_t*)((unsigned char*)p.out + RG);
  float* const MODP = (float*)(ws + WS_MODP); float* const MOD = (float*)(ws + WS_MOD);
  const float* xp = p.in[0]; const float* xs = p.in[1];
  pg8::StaticOrder S;
  volatile LAS unsigned* xst = (volatile LAS unsigned*)(lds + XST_OFF);
  if (threadIdx.x < 4) xst[threadIdx.x] = 0u;
  __syncthreads();
  const XcdBarrier xb = xcd_barrier_post((unsigned*)(ws + WS_BAR), xst);

  for (int rep = 0; rep < REP_P0; ++rep) {
    const int tid = opaque_tid();
    LAS float* tile = (LAS float*)lds;
    transpose_job<true>(tile, p.in[10], 8576, (bf16_t*)(ws + WS_WIN), 8704, 1024);
    if (gridDim.x != 256) {
    transpose_job<false>(tile, p.in[22], 1024, (bf16_t*)(ws + WS_WPA), 1024, 1024);
    transpose_job<false>(tile, p.in[23], 1024, (bf16_t*)(ws + WS_WPB), 1024, 1024);
    transpose_job<false>(tile, p.in[24], 1024, (bf16_t*)(ws + WS_WO), 1024, 1024);
    transpose_job<false>(tile, p.in[15], 1024, (bf16_t*)(ws + WS_G2T), 1024, 128); }
    for (int d = 0; d < 2; ++d) {
      transpose_job<false>(tile, p.in[12] + (size_t)d * 64 * 1024, 1024, (bf16_t*)(ws + WS_W2T) + (size_t)d * 1024 * 64, 1024, 64);
      transpose_job<false>(tile, p.in[14] + (size_t)d * 64 * 1024, 1024, (bf16_t*)(ws + WS_A2T) + (size_t)d * 1024 * 64, 1024, 64);
    }
    LAS float* sl = (LAS float*)lds;
    for (int ib = blockIdx.x; ib < 32 * 12; ib += gridDim.x) {
      const int kc = ib / 12, j = (ib % 12) * 512 + tid;
      __syncthreads();
      if (tid < 160) { const int i = tid >> 5, k = kc * 32 + (tid & 31); const float c = (i == 0) ? p.in[5][k] : p.in[4][(i - 1) * 1024 + k]; sl[tid] = c / (1.0f + __expf(-c)); }
      __syncthreads();
      float s[5] = {0.f, 0.f, 0.f, 0.f, 0.f};
      const float* wp = p.in[8] + (size_t)(kc * 32) * 6144 + j;
#pragma unroll 8
      for (int k = 0; k < 32; ++k) { const float w = wp[(size_t)k * 6144];
#pragma unroll
        for (int i = 0; i < 5; ++i) s[i] += sl[i * 32 + k] * w; }
#pragma unroll
      for (int i = 0; i < 5; ++i) MODP[((size_t)kc * 5 + i) * 6144 + j] = s[i];
    }
  }
  if (p.ws == nullptr) grid.sync();
  xcd_barrier(xb);
  for (int idx = blockIdx.x * 512 + opaque_tid(); idx < 5 * 6144; idx += gridDim.x * 512) {
    const int j = idx % 6144; float s = p.in[9][j];
    for (int kc = 0; kc < 32; ++kc) s += MODP[(size_t)kc * 5 * 6144 + idx];
    MOD[idx] = s;
  }
  xcd_barrier(xb);
  norm_rows<0>(xp, xs, p.in[6], MOD, 0, 1024, D0, nullptr);
  xcd_barrier(xb);
  { pg8::Gemm g{D0, (const bf16_t*)(ws + WS_WIN), NT, 6656, 1024, 1024}; S.init(NT, 6656, gridDim.x, blockIdx.x);
    EpiIn E{rR, rK, rV, rCB, rU, rLOR}; pg8::gemm_phase(lds, g, S, E); }
  xcd_barrier(xb);
  {
    const bool stream = (gridDim.x == 256);
    for (int u = blockIdx.x; u < (stream ? 256 : 256 + 1024); u += gridDim.x) {
      int h, dir, half, tb0 = 0, n0 = 0, tb1 = 0, tbs = 0, ns1 = 0; const float* s0 = nullptr; float* so1 = nullptr; size_t sos = 0;
      if (u < 256) { const int b = u >> 6; h = (u >> 2) & 15; dir = (u >> 1) & 1; half = u & 1;
        tb0 = NCTX + b * 4096; n0 = 64; s0 = p.in[2 + dir] + (size_t)(b * 16 + h) * 4096;
        if (stream) { tb1 = b * 256; tbs = 4 * 256; ns1 = 4; sos = (size_t)4 * 16 * 4096;
          so1 = p.out + (size_t)NT * DM + (size_t)dir * (16 * 16 * 4096) + (size_t)(b * 16 + h) * 4096; }
      } else { const int cu = u - 256; const int b = cu >> 6; h = (cu >> 2) & 15; dir = (cu >> 1) & 1; half = cu & 1;
        tb1 = b * 256; ns1 = 1; so1 = p.out + (size_t)NT * DM + (size_t)dir * (16 * 16 * 4096) + (size_t)(b * 16 + h) * 4096; }
      if (dir) scan_unit<1>(p, lds, h, half, tb0, n0, s0, tb1, tbs, 4, ns1, so1, sos, D1, stream);
      else scan_unit<0>(p, lds, h, half, tb0, n0, s0, tb1, tbs, 4, ns1, so1, sos, D0, stream);
    }
  }
  xcd_barrier(xb);
  {
    const int tid = opaque_tid(), lane = tid & 63, wid = tid >> 6;
    const bf16_t* G2T = (const bf16_t*)(ws + WS_G2T); const float* C3 = (const float*)(ws + WS_C3);
    const int gw = blockIdx.x * 8 + wid, nw = gridDim.x * 8; const int tk = lane & 15, q = lane >> 4;
    const int tpw = (NT / 16 + gridDim.x - 1) / gridDim.x;
    for (int rep = 0; rep < REP_P7; ++rep)
    for (int e = 0; e < 2; ++e) {
      const int h = wid * 2 + e;
      bf16x8 gfr[4][4]; f32x4 lw[4], lb[4];
#pragma unroll
      for (int nt = 0; nt < 4; ++nt) { lw[nt] = *(const f32x4*)(p.in[19] + h * 64 + q * 16 + nt * 4); lb[nt] = *(const f32x4*)(p.in[20] + h * 64 + q * 16 + nt * 4);
#pragma unroll
        for (int ks = 0; ks < 4; ++ks) gfr[nt][ks] = *(const bf16x8*)(G2T + (size_t)(h * 64 + (tk >> 2) * 16 + nt * 4 + (tk & 3)) * 128 + ks * 32 + q * 8); }
      for (int k = 0; k < tpw; ++k) {
        const int tt = blockIdx.x * tpw + k; if (tt >= NT / 16) break;
        const int tok = tt * 16 + tk;
        bf16x8 sfr[4];
#pragma unroll
        for (int ks = 0; ks < 4; ++ks) sfr[ks] = *(const bf16x8*)(rLOR + (size_t)tok * 384 + 256 + ks * 32 + q * 8);
        const float c3s = C3[(size_t)tok * 16 + h] + C3[((size_t)NT + tok) * 16 + h];
        const size_t off = (size_t)tok * DM + h * 64 + q * 16;
        const u32x4 yfa = *(const u32x4*)(D0 + off), yfb = *(const u32x4*)(D0 + off + 8), yba = *(const u32x4*)(D1 + off), ybb = *(const u32x4*)(D1 + off + 8);
        const u32x4 va = *(const u32x4*)(rV + off), vb = *(const u32x4*)(rV + off + 8);
        f32x4 go[4]; float wkv[4][4], vv[4][4]; float sm = 0.f;
#pragma unroll
        for (int nt = 0; nt < 4; ++nt) {
          const unsigned yf0 = (nt < 2) ? yfa[2 * nt] : yfb[2 * nt - 4], yf1 = (nt < 2) ? yfa[2 * nt + 1] : yfb[2 * nt - 3];
          const unsigned yb0 = (nt < 2) ? yba[2 * nt] : ybb[2 * nt - 4], yb1 = (nt < 2) ? yba[2 * nt + 1] : ybb[2 * nt - 3];
          const unsigned v0 = (nt < 2) ? va[2 * nt] : vb[2 * nt - 4], v1 = (nt < 2) ? va[2 * nt + 1] : vb[2 * nt - 3];
          f32x4 z = {0.f, 0.f, 0.f, 0.f};
#pragma unroll
          for (int ks = 0; ks < 4; ++ks) z = __builtin_amdgcn_mfma_f32_16x16x32_bf16(gfr[nt][ks], sfr[ks], z, 0, 0, 0);
          go[nt] = z;
          wkv[nt][0] = lo_bf(yf0) + lo_bf(yb0); wkv[nt][1] = hi_bf(yf0) + hi_bf(yb0); wkv[nt][2] = lo_bf(yf1) + lo_bf(yb1); wkv[nt][3] = hi_bf(yf1) + hi_bf(yb1);
          vv[nt][0] = lo_bf(v0); vv[nt][1] = hi_bf(v0); vv[nt][2] = lo_bf(v1); vv[nt][3] = hi_bf(v1);
          sm += wkv[nt][0] + wkv[nt][1] + wkv[nt][2] + wkv[nt][3];
        }
        sm += __shfl_xor(sm, 16); sm += __shfl_xor(sm, 32);
        const float mu = sm * (1.0f / 64.0f); float s2 = 0.f;
#pragma unroll
        for (int nt = 0; nt < 4; ++nt)
#pragma unroll
          for (int j = 0; j < 4; ++j) { const float d = wkv[nt][j] - mu; s2 += d * d; }
        s2 += __shfl_xor(s2, 16); s2 += __shfl_xor(s2, 32);
        const float rs = rsqrtf(s2 * (1.0f / 64.0f) + 64e-5f);
        u32x4 oa, ob2;
#pragma unroll
        for (int nt = 0; nt < 4; ++nt) {
          float o[4];
#pragma unroll
          for (int j = 0; j < 4; ++j) o[j] = ((wkv[nt][j] - mu) * rs * lw[nt][j] + lb[nt][j] + c3s * vv[nt][j]) * go[nt][j];
          const unsigned p0 = cvt_pk_bf16(o[0], o[1]), p1 = cvt_pk_bf16(o[2], o[3]);
          if (nt < 2) { oa[2 * nt] = p0; oa[2 * nt + 1] = p1; } else { ob2[2 * nt - 4] = p0; ob2[2 * nt - 3] = p1; } }
        *(u32x4*)(rR + off) = oa; *(u32x4*)(rR + off + 8) = ob2;
      }
    }
    norm_rows<0>(xp, xs, p.in[6], MOD, 0, 1024, rK, nullptr);
    const float* cw = p.in[21];
    const int rpw = (NT + gridDim.x - 1) / gridDim.x;
    if (gridDim.x != 256) { const int c0 = (tid & 127) * 8;
      float w0[8], w1[8], w2[8];
#pragma unroll
      for (int i = 0; i < 8; ++i) { w0[i] = cw[c0 + i]; w1[i] = cw[1024 + c0 + i]; w2[i] = cw[2048 + c0 + i]; }
      for (int li = tid; li < rpw * 128; li += 512) {
        const int tok = blockIdx.x * rpw + (li >> 7); if (tok >= NT) break;
        const int Wm = (tok < NCTX) ? 255 : 63; const int pos = tok & Wm;
        const size_t off = (size_t)tok * DM + c0;
        const u32x4 uc = *(const u32x4*)(rU + off), cbv = *(const u32x4*)(rCB + off);
        u32x4 up = {0u, 0u, 0u, 0u}, un = {0u, 0u, 0u, 0u};
        if (pos != 0) up = *(const u32x4*)(rU + off - DM);
        if (pos != Wm) un = *(const u32x4*)(rU + off + DM);
        float o[8];
#pragma unroll
        for (int i = 0; i < 4; ++i) {
          o[2 * i] = lo_bf(cbv[i]) * (w0[2 * i] * lo_bf(up[i]) + w1[2 * i] * lo_bf(uc[i]) + w2[2 * i] * lo_bf(un[i]));
          o[2 * i + 1] = hi_bf(cbv[i]) * (w0[2 * i + 1] * hi_bf(up[i]) + w1[2 * i + 1] * hi_bf(uc[i]) + w2[2 * i + 1] * hi_bf(un[i]));
        }
        u32x4 ob; ob[0] = cvt_pk_bf16(o[0], o[1]); ob[1] = cvt_pk_bf16(o[2], o[3]); ob[2] = cvt_pk_bf16(o[4], o[5]); ob[3] = cvt_pk_bf16(o[6], o[7]);
        *(u32x4*)(rCB + off) = ob;
      }
    }
  }
  xcd_barrier(xb);
  { pg8::Gemm g{rK, (const bf16_t*)(ws + WS_WIN) + (size_t)6656 * 1024, NT, 3072, 1024, 1024, rCB, (const bf16_t*)(ws + WS_WPB), 8}; S.init(NT, 3072, gridDim.x, blockIdx.x);
    EpiGate E{D0, D1, rU}; pg8::gemm_phase(lds, g, S, E); }
  xcd_barrier(xb);
  { pg8::Gemm g{rR, (const bf16_t*)(ws + WS_WPA), NT, 1024, 1024, 1024}; S.init(NT, 1024, gridDim.x, blockIdx.x);
    EpiYa E{D0, D1, rU}; pg8::gemm_phase(lds, g, S, E); }
  xcd_barrier(xb);
  { pg8::Gemm g{rU, (const bf16_t*)(ws + WS_WO), NT, 1024, 1024, 1024}; S.init(NT, 1024, gridDim.x, blockIdx.x);
    EpiResB<true> E{xp, xs, nullptr, D0, MOD + 2048, 0}; pg8::gemm_phase(lds, g, S, E); }
  xcd_barrier(xb);
  norm_rows<0, true>(nullptr, nullptr, p.in[7], MOD, 3072, 4096, rV, nullptr, D0);
  if (gridDim.x != 256) { LAS float* tile = (LAS float*)lds;
    transpose_job<false>(tile, p.in[25], 4096, (bf16_t*)(ws + WS_WFF1), 4096, 1024);
    transpose_job<false>(tile, p.in[26], 1024, (bf16_t*)(ws + WS_WFF2), 1024, 4096); }
  xcd_barrier(xb);
  { pg8::Gemm g{rV, (const bf16_t*)(ws + WS_WFF1), NT, 4096, 1024, 1024}; S.init(NT, 4096, gridDim.x, blockIdx.x);
    EpiFf1 E{rR}; pg8::gemm_phase(lds, g, S, E);
#if REP_P12 > 1
    __syncthreads(); pg8::gemm_phase(lds, g, S, E);
#endif
  }
  xcd_barrier(xb);
  { pg8::Gemm g{rR, (const bf16_t*)(ws + WS_WFF2), 16384, 1024, 4096, 4096}; S.init(16384, 1024, gridDim.x, blockIdx.x);
    EpiResB<false> E{nullptr, nullptr, D0, rV, MOD + 5120, 0}; pg8::gemm_phase(lds, g, S, E); }
  { pg8::Gemm g{rR + (size_t)16384 * 4096, (const bf16_t*)(ws + WS_WFF2), 4096, 1024, 2048, 4096}; S.init(4096, 1024, gridDim.x, blockIdx.x, 2);
    EpiFf2Split E{D0, rV, MOD + 5120, (bf16_t*)(ws + WS_LOR), 16384}; pg8::gemm_phase(lds, g, S, E); }
  xcd_barrier(xb);
  norm_rows<1, true>(nullptr, nullptr, p.in[27], MOD, 5120, 0, (bf16_t*)(ws + WS_LOR), p.out, rV);
}

extern "C" void kernel_launch(void* const* d_in, const int* in_sizes, int n_in,
                              void* d_out, int out_size, void* d_ws, size_t ws_size,
                              hipStream_t stream) {
  static int grid_blocks = 0;
  if (!grid_blocks) {
    int dev = 0, cus = 0, per_cu = 0;
    (void)hipGetDevice(&dev);
    (void)hipDeviceGetAttribute(&cus, hipDeviceAttributeMultiprocessorCount, dev);
    (void)hipFuncSetAttribute((const void*)mega, hipFuncAttributeMaxDynamicSharedMemorySize, LDS_BYTES);
    (void)hipOccupancyMaxActiveBlocksPerMultiprocessor(&per_cu, (const void*)mega, 512, LDS_BYTES);
    if (per_cu < 1) { fprintf(stderr, "occupancy query reports %d blocks per CU\n", per_cu); per_cu = 1; }
    grid_blocks = cus;
    if (ws_size < WS_END + (size_t)8 * 1024 * 1024) fprintf(stderr, "workspace too small: %zu < %zu\n", ws_size, (size_t)WS_END);
  }
  Params p{};
  for (int i = 0; i < 28 && i < n_in; ++i) p.in[i] = (const float*)d_in[i];
  p.out = (float*)d_out;
  p.ws = (unsigned char*)d_ws;
  (void)hipMemsetAsync((unsigned char*)d_ws + WS_BAR, 0, (size_t)3456 * 4, stream);
  void* args[] = {&p};
  hipError_t e = hipLaunchCooperativeKernel((void*)mega, dim3(grid_blocks), dim3(512), args, LDS_BYTES, stream);
  if (e != hipSuccess) fprintf(stderr, "cooperative launch failed: %s (grid %d)\n", hipGetErrorString(e), grid_blocks);
}
```

```cpp
#include <hip/hip_runtime.h>
#include <hip/hip_cooperative_groups.h>
#include <cstdio>
namespace cg = cooperative_groups;

#define LAS __attribute__((address_space(3)))
typedef unsigned short bf16_t;
typedef short bf16x8 __attribute__((ext_vector_type(8)));
typedef float f32x4 __attribute__((ext_vector_type(4)));
typedef unsigned u32x4 __attribute__((ext_vector_type(4)));
typedef unsigned u32x2 __attribute__((ext_vector_type(2)));

constexpr int NT = 20480;
constexpr int NCTX = 4096;
constexpr int DM = 1024;
constexpr size_t RG = (size_t)NT * DM * 2;
constexpr size_t WS_R = 0, WS_K = RG, WS_CB = 2 * RG, WS_U = 3 * RG, WS_V = 4 * RG;
constexpr size_t WS_LOR = 5 * RG;
constexpr size_t WS_WIN = WS_LOR + (size_t)NT * 384 * 2;
constexpr size_t WS_WPA = WS_WIN + (size_t)8704 * 1024 * 2;
constexpr size_t WS_WPB = WS_WPA + (size_t)1024 * 1024 * 2;
constexpr size_t WS_WO = WS_WPB + (size_t)1024 * 1024 * 2;
constexpr size_t WS_W2T = WS_WO + (size_t)1024 * 1024 * 2;
constexpr size_t WS_A2T = WS_W2T + (size_t)2 * 1024 * 64 * 2;
constexpr size_t WS_G2T = WS_A2T + (size_t)2 * 1024 * 64 * 2;
constexpr size_t WS_MODP = WS_G2T + (size_t)1024 * 128 * 2;
constexpr size_t WS_MOD = WS_MODP + (size_t)32 * 5 * 6144 * 4;
constexpr size_t WS_C3 = WS_MOD + (size_t)5 * 6144 * 4;
constexpr size_t WS_BAR = WS_C3 + (size_t)2 * NT * 16 * 4;
constexpr size_t WS_END = WS_BAR + (size_t)3456 * 4;
constexpr size_t WS_WFF1 = WS_WIN, WS_WFF2 = WS_END;
constexpr int XST_OFF = 151040;
constexpr int SC_TT = XST_OFF + 16;
constexpr int LDS_BYTES = SC_TT + 2 * 4224;
#ifndef REP_SCAN
#define REP_SCAN 1
#endif
#ifndef REP_P2
#define REP_P2 1
#endif
#ifndef REP_P12
#define REP_P12 1
#endif
#ifndef REP_P7
#define REP_P7 1
#endif
#ifndef REP_P0
#define REP_P0 1
#endif


struct Params {
  const float* in[28];
  float* out;
  unsigned char* ws;
};

__device__ __forceinline__ float bf2f(unsigned b) { return __uint_as_float(b << 16); }
typedef __bf16 bf16v2_t __attribute__((ext_vector_type(2)));
typedef float f32v2_t __attribute__((ext_vector_type(2)));
__device__ __forceinline__ unsigned cvt_pk_bf16(float lo, float hi) { const f32v2_t f = {lo, hi}; const bf16v2_t r = __builtin_convertvector(f, bf16v2_t); return __builtin_bit_cast(unsigned, r); }
__device__ __forceinline__ float lo_bf(unsigned u) { return __uint_as_float(u << 16); }
__device__ __forceinline__ float hi_bf(unsigned u) { return __uint_as_float(u & 0xffff0000u); }
__device__ __forceinline__ float sigmoidf_(float x) { return __builtin_amdgcn_rcpf(1.0f + __expf(-x)); }
template <int CTRL> __device__ __forceinline__ float dppf(float x) {
  return __int_as_float(__builtin_amdgcn_update_dpp(0, __float_as_int(x), CTRL, 0xF, 0xF, true));
}
template <int CTRL> __device__ __forceinline__ float dppo(float oldv, float x) {
  return __int_as_float(__builtin_amdgcn_update_dpp(__float_as_int(oldv), __float_as_int(x), CTRL, 0xF, 0xF, false));
}
__device__ __forceinline__ float sum8(float x) { x += dppf<0xB1>(x); x += dppf<0x4E>(x); x += dppf<0x141>(x); return x; }
__device__ __forceinline__ float sum16(float x) { x = sum8(x); x += dppf<0x140>(x); return x; }
__device__ __forceinline__ float wave_sum(float x) {
  x = sum16(x); x += __shfl_xor(x, 16); x += __shfl_xor(x, 32); return x;
}
__device__ __forceinline__ int opaque_tid() { int t = threadIdx.x; asm volatile("" : "+v"(t)); return t; }
__device__ __forceinline__ __amdgpu_buffer_rsrc_t wt_rsrc(const void* base) { return __builtin_amdgcn_make_buffer_rsrc(const_cast<void*>(base), 0, 0x7fffffff, 0x00020000); }
__device__ __forceinline__ void st16_wt(const __amdgpu_buffer_rsrc_t& rs, const void* base, const void* p, u32x4 v) {
  __builtin_amdgcn_raw_buffer_store_b128(v, rs, (unsigned)((const char*)p - (const char*)base), 0, 16); }
__device__ __forceinline__ void st8_wt(const __amdgpu_buffer_rsrc_t& rs, const void* base, const void* p, u32x2 v) {
  __builtin_amdgcn_raw_buffer_store_b64(v, rs, (unsigned)((const char*)p - (const char*)base), 0, 16); }
__device__ __forceinline__ int mod_index(int row) { return row < NCTX ? 0 : 1 + ((row - NCTX) >> 12); }

namespace pg8 {
constexpr int BM = 256, BK = 64, HALF = 128, HTB = HALF * BK * 2, STAGE_BYTES = 8 * HTB, NXCD = 8, WGM = 8;
__device__ __forceinline__ int lds_byte(int r, int c) { const int st = (r >> 4) * 2 + (c >> 5), rr = r & 15, cc = c & 31, ob = rr * 64 + cc * 2; return st * 1024 + (ob ^ (((ob >> 9) & 1) << 5)); }
__device__ __forceinline__ void stage_rc(int b, int& R, int& C) { const int st = b / 1024, sb = b % 1024, swz = sb ^ (((sb >> 9) & 1) << 5); R = (st >> 1) * 16 + swz / 64; C = (st & 1) * 32 + (swz % 64) / 2; }
__device__ __forceinline__ int perm32(int rho) { const int n = rho >> 4, i = rho & 15; return 8 * (i >> 2) + 4 * n + (i & 3); }
struct Unit { int pm, pn, ks; };
struct Gemm { const bf16_t* A; const bf16_t* Bt; int M, N, K, ld; const bf16_t* A2 = nullptr; const bf16_t* Bt2 = nullptr; int nsplit = 1 << 30; };
struct StaticOrder {
  int nM, nN, nwg, G, c, nNr;
  __device__ void init(int M, int N, int G_, int c_, int ksplit = 1) { nM = M / BM; nNr = N / BM; nN = nNr * ksplit; nwg = nM * nN; G = G_; c = c_; }
  __device__ bool next(int i, Unit& u) const {
    const long L = (long)i * G + c; if (L >= nwg) return false;
    int wgid = (int)L; { const int q = nwg / NXCD, r = nwg % NXCD, xcd = wgid % NXCD, off = wgid / NXCD; wgid = (xcd < r ? xcd * (q + 1) : r * (q + 1) + (xcd - r) * q) + off; }
    const int nig = WGM * nN, gid = wgid / nig, fm = gid * WGM, gsz = (nM - fm) < WGM ? (nM - fm) : WGM;
    u.pm = fm + ((wgid % nig) % gsz); const int pv = (wgid % nig) / gsz; u.pn = pv % nNr; u.ks = pv / nNr; return true;
  }
};
template <class Epi>
__device__ __forceinline__ void gemm_phase(LAS unsigned char* lds, const Gemm g, const StaticOrder& S, const Epi& E) {
  const int tid = opaque_tid(), wid = __builtin_amdgcn_readfirstlane(tid >> 6), lane = tid & 63, wr = wid >> 2, wc = wid & 3, fr = lane & 15, fq = lane >> 4;
  const int K = g.K, nt = K / BK, LD = g.ld;
  unsigned voffA[2], voffB[2];
#pragma unroll
  for (int i = 0; i < 2; ++i) { int R, C; stage_rc(tid * 16 + i * 8192, R, C); const int Rb = Epi::PERM ? ((R & ~31) + perm32(R & 31)) : R;
    voffA[i] = (unsigned)(R * LD + C) * 2u; voffB[i] = (unsigned)(Rb * LD + C) * 2u; }
  const size_t kstep = (size_t)(BK * 2);
  const size_t hstep = (size_t)HALF * LD * 2;
  const size_t ksb = (size_t)K * 2;
  const size_t tstep = 2 * hstep;
  const unsigned ldsw = (unsigned)wid * 1024u;
  const int aoff = lds_byte(wr * 64 + fr, fq * 8), boff = lds_byte(wc * 32 + fr, fq * 8);
#define PG8_SA(b, h) (((b) * 2 + (h)) * HTB)
#define PG8_SB(b, h) ((4 + (b) * 2 + (h)) * HTB)
#define PG8_STAGE(bufoff, gbase, voff) do { _Pragma("unroll") for (int _i = 0; _i < 2; ++_i) \
    __builtin_amdgcn_global_load_lds((const unsigned*)((const char*)(gbase) + (voff)[_i]), (LAS unsigned*)(lds + (bufoff) + ldsw + _i * 8192), 16, 0, 0); } while (0)
#define PG8_LDA(dst, b, h) do { _Pragma("unroll") for (int m = 0; m < 4; ++m) _Pragma("unroll") for (int k = 0; k < 2; ++k) dst[m][k] = *(const LAS bf16x8*)(lds + PG8_SA(b, h) + aoff + m * 2048 + k * 1024); } while (0)
#define PG8_LDB(dst, b, h) do { _Pragma("unroll") for (int n = 0; n < 2; ++n) _Pragma("unroll") for (int k = 0; k < 2; ++k) dst[n][k] = *(const LAS bf16x8*)(lds + PG8_SB(b, h) + boff + n * 2048 + k * 1024); } while (0)
#define PG8_MMA(ai, bj, At, Bt) do { __builtin_amdgcn_s_setprio(1); _Pragma("unroll") for (int m = 0; m < 4; ++m) _Pragma("unroll") for (int n = 0; n < 2; ++n) _Pragma("unroll") for (int k = 0; k < 2; ++k) \
    acc[ai][bj][m][n] = __builtin_amdgcn_mfma_f32_16x16x32_bf16(Bt[n][k], At[m][k], acc[ai][bj][m][n], 0, 0, 0); __builtin_amdgcn_s_setprio(0); } while (0)
#define PG8_WAIT_V(n) asm volatile("s_waitcnt vmcnt(" #n ")" ::: "memory")
#define PG8_WAIT_L(n) asm volatile("s_waitcnt lgkmcnt(" #n ")" ::: "memory")
#define PG8_BAR __builtin_amdgcn_s_barrier()
#define PG8_SCHED __builtin_amdgcn_sched_barrier(0)
  Unit cur, nxt; int ui = 0;
  if (!S.next(0, cur)) return;
  f32x4 acc[2][2][4][2];
#pragma unroll
  for (int a = 0; a < 2; ++a)
#pragma unroll
    for (int b = 0; b < 2; ++b)
#pragma unroll
      for (int m = 0; m < 4; ++m)
#pragma unroll
        for (int n = 0; n < 2; ++n) acc[a][b][m][n] = (f32x4){0.f, 0.f, 0.f, 0.f};
  bf16x8 At[4][2], B0[2][2], B1[2][2];
  const long dA2 = g.A2 ? (long)((const char*)g.A2 - (const char*)g.A) : 0L;
  const long dB2 = g.Bt2 ? (long)((const char*)g.Bt2 - (const char*)g.Bt) - (long)g.nsplit * (long)tstep : 0L;
#define PG8_UA(u_) ((const char*)g.A + (size_t)(u_).pm * tstep + (size_t)(u_).ks * ksb + ((u_).pn >= g.nsplit ? dA2 : 0L))
#define PG8_UB(u_) ((const char*)g.Bt + (size_t)(u_).pn * tstep + (size_t)(u_).ks * ksb + ((u_).pn >= g.nsplit ? dB2 : 0L))
  const char* cA = PG8_UA(cur); const char* cB = PG8_UB(cur);
  PG8_STAGE(PG8_SB(0, 0), cB, voffB); PG8_STAGE(PG8_SA(0, 0), cA, voffA); PG8_STAGE(PG8_SB(0, 1), cB + hstep, voffB); PG8_STAGE(PG8_SA(0, 1), cA + hstep, voffA);
  if (wr == 1) PG8_BAR;
  PG8_WAIT_V(4); PG8_BAR;
  PG8_STAGE(PG8_SB(1, 0), cB + kstep, voffB); PG8_STAGE(PG8_SA(1, 0), cA + kstep, voffA); PG8_STAGE(PG8_SB(1, 1), cB + hstep + kstep, voffB);
  PG8_WAIT_V(6); PG8_BAR;
  for (;;) {
    const bool has_next = S.next(ui + 1, nxt);
    const char* nA = has_next ? PG8_UA(nxt) : cA; const char* nB = has_next ? PG8_UB(nxt) : cB;
    for (int t = 0; t < nt; t += 2) {
      const bool last = (t == nt - 2);
      const char* a1 = cA + (size_t)(t + 1) * kstep;
      const char* a2 = last ? nA : cA + (size_t)(t + 2) * kstep; const char* b2 = last ? nB : cB + (size_t)(t + 2) * kstep;
      const char* a3 = a2 + kstep; const char* b3 = b2 + kstep;
      PG8_LDB(B0, 0, 0); PG8_SCHED; PG8_LDA(At, 0, 0); PG8_STAGE(PG8_SA(1, 1), a1 + hstep, voffA);
      PG8_WAIT_L(8); PG8_BAR; PG8_WAIT_L(0); PG8_MMA(0, 0, At, B0); PG8_BAR; PG8_SCHED;
      PG8_LDB(B1, 0, 1); PG8_STAGE(PG8_SB(0, 0), b2, voffB);
      PG8_BAR; PG8_WAIT_L(0); PG8_MMA(0, 1, At, B1); PG8_BAR;
      PG8_LDA(At, 0, 1); PG8_STAGE(PG8_SA(0, 0), a2, voffA);
      PG8_BAR; PG8_WAIT_L(0); PG8_MMA(1, 0, At, B0); PG8_BAR; PG8_SCHED;
      PG8_STAGE(PG8_SB(0, 1), b2 + hstep, voffB);
      PG8_WAIT_V(6); PG8_BAR; PG8_MMA(1, 1, At, B1); PG8_BAR;
      PG8_LDB(B0, 1, 0); PG8_SCHED; PG8_LDA(At, 1, 0); PG8_STAGE(PG8_SA(0, 1), a2 + hstep, voffA);
      PG8_WAIT_L(8); PG8_BAR; PG8_WAIT_L(0); PG8_MMA(0, 0, At, B0); PG8_BAR; PG8_SCHED;
      PG8_LDB(B1, 1, 1); PG8_STAGE(PG8_SB(1, 0), b3, voffB);
      PG8_BAR; PG8_WAIT_L(0); PG8_MMA(0, 1, At, B1); PG8_BAR;
      PG8_LDA(At, 1, 1); PG8_STAGE(PG8_SA(1, 0), a3, voffA);
      PG8_BAR; PG8_WAIT_L(0); PG8_MMA(1, 0, At, B0); PG8_BAR; PG8_SCHED;
      PG8_STAGE(PG8_SB(1, 1), b3 + hstep, voffB);
      PG8_WAIT_V(6); PG8_BAR; PG8_MMA(1, 1, At, B1); PG8_BAR;
    }
    E(acc, cur, wr, wc, fr, fq);
    if (!has_next) break;
#pragma unroll
    for (int a = 0; a < 2; ++a)
#pragma unroll
      for (int b = 0; b < 2; ++b)
#pragma unroll
        for (int m = 0; m < 4; ++m)
#pragma unroll
          for (int n = 0; n < 2; ++n) acc[a][b][m][n] = (f32x4){0.f, 0.f, 0.f, 0.f};
    cur = nxt; cA = nA; cB = nB; ++ui;
  }
  PG8_WAIT_V(0);
  if (wr == 0) PG8_BAR;
  PG8_BAR;
#undef PG8_UA
#undef PG8_UB
#undef PG8_SA
#undef PG8_SB
#undef PG8_STAGE
#undef PG8_LDA
#undef PG8_LDB
#undef PG8_MMA
#undef PG8_WAIT_V
#undef PG8_WAIT_L
#undef PG8_BAR
#undef PG8_SCHED
}
}
using pg8::Unit;
typedef f32x4 AccT[2][2][4][2];

struct EpiIn {
  static constexpr bool PERM = true;
  bf16_t *R, *K, *V, *CB, *U, *LOR;
  __device__ __forceinline__ void operator()(const AccT& acc, const Unit& u, int wr, int wc, int fr, int fq) const {
    const int row0 = u.pm * 256 + wr * 64 + fr;
    const __amdgpu_buffer_rsrc_t rs = wt_rsrc(R);
    if (u.pn < 16) {
      bf16_t* base = (u.pn < 4) ? R : (u.pn < 8) ? K : (u.pn < 12) ? V : CB;
      const int col0 = (u.pn & 3) * 256 + wc * 32 + 8 * fq;
#pragma unroll
      for (int ai = 0; ai < 2; ++ai)
#pragma unroll
        for (int m = 0; m < 4; ++m) { bf16_t* rowp = base + (size_t)(row0 + ai * 128 + m * 16) * DM + col0;
#pragma unroll
          for (int bj = 0; bj < 2; ++bj) { const f32x4 v0 = acc[ai][bj][m][0], v1 = acc[ai][bj][m][1];
            u32x4 o; o[0] = cvt_pk_bf16(v0[0], v0[1]); o[1] = cvt_pk_bf16(v0[2], v0[3]); o[2] = cvt_pk_bf16(v1[0], v1[1]); o[3] = cvt_pk_bf16(v1[2], v1[3]);
            st16_wt(rs, R, rowp + bj * 128, o); } }
    } else if (u.pn < 24) {
      const int ch0 = (u.pn - 16) * 128 + wc * 32 + 8 * fq;
#pragma unroll
      for (int ai = 0; ai < 2; ++ai)
#pragma unroll
        for (int m = 0; m < 4; ++m) { bf16_t* rowp = U + (size_t)(row0 + ai * 128 + m * 16) * DM + ch0;
          const f32x4 p0 = acc[ai][0][m][0] * acc[ai][0][m][1], p1 = acc[ai][1][m][0] * acc[ai][1][m][1];
          u32x4 o; o[0] = cvt_pk_bf16(p0[0], p0[1]); o[1] = cvt_pk_bf16(p0[2], p0[3]); o[2] = cvt_pk_bf16(p1[0], p1[1]); o[3] = cvt_pk_bf16(p1[2], p1[3]);
          st16_wt(rs, R, rowp, o); }
    } else {
      const int colw = wc * 32 + 8 * fq;
#pragma unroll
      for (int ai = 0; ai < 2; ++ai)
#pragma unroll
        for (int m = 0; m < 4; ++m) { bf16_t* rowp = LOR + (size_t)(row0 + ai * 128 + m * 16) * 384;
#pragma unroll
          for (int bj = 0; bj < 2; ++bj) {
            f32x4 v0 = acc[ai][bj][m][0], v1 = acc[ai][bj][m][1];
            if (u.pn == 24) {
              if (bj == 0) {
#pragma unroll
                for (int j = 0; j < 4; ++j) { v0[j] = 1.0f - 2.0f * __builtin_amdgcn_rcpf(1.0f + __expf(2.0f * v0[j])); v1[j] = 1.0f - 2.0f * __builtin_amdgcn_rcpf(1.0f + __expf(2.0f * v1[j])); }
              }
              u32x4 o; o[0] = cvt_pk_bf16(v0[0], v0[1]); o[1] = cvt_pk_bf16(v0[2], v0[3]); o[2] = cvt_pk_bf16(v1[0], v1[1]); o[3] = cvt_pk_bf16(v1[2], v1[3]);
              *(u32x4*)(rowp + bj * 128 + colw) = o;
            } else if (bj == 0) {
#pragma unroll
              for (int j = 0; j < 4; ++j) { v0[j] = sigmoidf_(v0[j]); v1[j] = sigmoidf_(v1[j]); }
              u32x4 o; o[0] = cvt_pk_bf16(v0[0], v0[1]); o[1] = cvt_pk_bf16(v0[2], v0[3]); o[2] = cvt_pk_bf16(v1[0], v1[1]); o[3] = cvt_pk_bf16(v1[2], v1[3]);
              *(u32x4*)(rowp + 256 + colw) = o;
            }
          } }
    }
  }
};
struct EpiGate {
  static constexpr bool PERM = true;
  bf16_t *GA, *GB, *YR;
  __device__ __forceinline__ void operator()(const AccT& acc, const Unit& u, int wr, int wc, int fr, int fq) const {
    const int row0 = u.pm * 256 + wr * 64 + fr;
    long boff = 0L; if (u.pn >= 4) boff = (long)((char*)GB - (char*)GA); if (u.pn >= 8) boff = (long)((char*)YR - (char*)GA);
    bf16_t* base = (bf16_t*)((char*)GA + boff);
    const bool sg = u.pn < 8;
    const int col0 = (u.pn & 3) * 256 + wc * 32 + 8 * fq;
#pragma unroll
    for (int ai = 0; ai < 2; ++ai)
#pragma unroll
      for (int m = 0; m < 4; ++m) { bf16_t* rowp = base + (size_t)(row0 + ai * 128 + m * 16) * DM + col0;
#pragma unroll
        for (int bj = 0; bj < 2; ++bj) { f32x4 v0 = acc[ai][bj][m][0], v1 = acc[ai][bj][m][1];
          if (sg) {
#pragma unroll
            for (int j = 0; j < 4; ++j) { v0[j] = sigmoidf_(v0[j]); v1[j] = sigmoidf_(v1[j]); } }
          u32x4 o; o[0] = cvt_pk_bf16(v0[0], v0[1]); o[1] = cvt_pk_bf16(v0[2], v0[3]); o[2] = cvt_pk_bf16(v1[0], v1[1]); o[3] = cvt_pk_bf16(v1[2], v1[3]);
          *(u32x4*)(rowp + bj * 128) = o; } }
  }
};
struct EpiYa {
  static constexpr bool PERM = true;
  const bf16_t* GA; const bf16_t* GB; bf16_t* O;
  __device__ __forceinline__ void operator()(const AccT& acc, const Unit& u, int wr, int wc, int fr, int fq) const {
    const int row0 = u.pm * 256 + wr * 64 + fr; const int col0 = u.pn * 256 + wc * 32 + 8 * fq;
#pragma unroll
    for (int ai = 0; ai < 2; ++ai)
#pragma unroll
      for (int m = 0; m < 4; ++m) { const size_t off = (size_t)(row0 + ai * 128 + m * 16) * DM + col0;
#pragma unroll
        for (int bj = 0; bj < 2; ++bj) { const f32x4 v0 = acc[ai][bj][m][0], v1 = acc[ai][bj][m][1];
          const u32x4 ga = *(const u32x4*)(GA + off + bj * 128), gb = *(const u32x4*)(GB + off + bj * 128), yr = *(const u32x4*)(O + off + bj * 128);
          float r[8];
          r[0] = lo_bf(ga[0]) * v0[0] + lo_bf(gb[0]) * lo_bf(yr[0]); r[1] = hi_bf(ga[0]) * v0[1] + hi_bf(gb[0]) * hi_bf(yr[0]);
          r[2] = lo_bf(ga[1]) * v0[2] + lo_bf(gb[1]) * lo_bf(yr[1]); r[3] = hi_bf(ga[1]) * v0[3] + hi_bf(gb[1]) * hi_bf(yr[1]);
          r[4] = lo_bf(ga[2]) * v1[0] + lo_bf(gb[2]) * lo_bf(yr[2]); r[5] = hi_bf(ga[2]) * v1[1] + hi_bf(gb[2]) * hi_bf(yr[2]);
          r[6] = lo_bf(ga[3]) * v1[2] + lo_bf(gb[3]) * lo_bf(yr[3]); r[7] = hi_bf(ga[3]) * v1[3] + hi_bf(gb[3]) * hi_bf(yr[3]);
          u32x4 o; o[0] = cvt_pk_bf16(r[0], r[1]); o[1] = cvt_pk_bf16(r[2], r[3]); o[2] = cvt_pk_bf16(r[4], r[5]); o[3] = cvt_pk_bf16(r[6], r[7]);
          *(u32x4*)(O + off + bj * 128) = o; } }
  }
};
template <bool ADD> struct EpiY {
  static constexpr bool PERM = true;
  const bf16_t* G; bf16_t* O;
  __device__ __forceinline__ void operator()(const AccT& acc, const Unit& u, int wr, int wc, int fr, int fq) const {
    const int row0 = u.pm * 256 + wr * 64 + fr; const int col0 = u.pn * 256 + wc * 32 + 8 * fq;
#pragma unroll
    for (int ai = 0; ai < 2; ++ai)
#pragma unroll
      for (int m = 0; m < 4; ++m) { const size_t off = (size_t)(row0 + ai * 128 + m * 16) * DM + col0;
#pragma unroll
        for (int bj = 0; bj < 2; ++bj) { const f32x4 v0 = acc[ai][bj][m][0], v1 = acc[ai][bj][m][1];
          const u32x4 g = *(const u32x4*)(G + off + bj * 128);
          float r[8];
          r[0] = lo_bf(g[0]) * v0[0]; r[1] = hi_bf(g[0]) * v0[1]; r[2] = lo_bf(g[1]) * v0[2]; r[3] = hi_bf(g[1]) * v0[3];
          r[4] = lo_bf(g[2]) * v1[0]; r[5] = hi_bf(g[2]) * v1[1]; r[6] = lo_bf(g[3]) * v1[2]; r[7] = hi_bf(g[3]) * v1[3];
          if (ADD) { const u32x4 p = *(const u32x4*)(O + off + bj * 128);
            r[0] += lo_bf(p[0]); r[1] += hi_bf(p[0]); r[2] += lo_bf(p[1]); r[3] += hi_bf(p[1]);
            r[4] += lo_bf(p[2]); r[5] += hi_bf(p[2]); r[6] += lo_bf(p[3]); r[7] += hi_bf(p[3]); }
          u32x4 o; o[0] = cvt_pk_bf16(r[0], r[1]); o[1] = cvt_pk_bf16(r[2], r[3]); o[2] = cvt_pk_bf16(r[4], r[5]); o[3] = cvt_pk_bf16(r[6], r[7]);
          *(u32x4*)(O + off + bj * 128) = o; } }
  }
};
struct EpiRes {
  static constexpr bool PERM = false;
  const float* x0; const float* x1; float* OUT; const float* gate;
  __device__ __forceinline__ void operator()(const AccT& acc, const Unit& u, int wr, int wc, int fr, int fq) const {
    const int rowt = u.pm * 256; const int mi = mod_index(rowt);
    const int row0 = rowt + wr * 64 + fr, col0 = u.pn * 256 + wc * 32 + 4 * fq;
    const float* gp = gate + (size_t)mi * 6144 + col0;
    f32x4 gv[2][2];
#pragma unroll
    for (int bj = 0; bj < 2; ++bj)
#pragma unroll
      for (int n = 0; n < 2; ++n) gv[bj][n] = *(const f32x4*)(gp + bj * 128 + n * 16);
#pragma unroll
    for (int ai = 0; ai < 2; ++ai)
#pragma unroll
      for (int m = 0; m < 4; ++m) { const int row = row0 + ai * 128 + m * 16;
        const float* xr = x0 ? ((row < NCTX) ? x0 + (size_t)row * DM : x1 + (size_t)(row - NCTX) * DM) : OUT + (size_t)row * DM;
        float* orow = OUT + (size_t)row * DM;
#pragma unroll
        for (int bj = 0; bj < 2; ++bj)
#pragma unroll
          for (int n = 0; n < 2; ++n) { const int c = col0 + bj * 128 + n * 16;
            const f32x4 xv = *(const f32x4*)(xr + c);
            *(f32x4*)(orow + c) = xv + gv[bj][n] * acc[ai][bj][m][n]; } }
  }
};
template <bool FROMX> struct EpiResB {
  static constexpr bool PERM = true;
  const float* x0; const float* x1; const bf16_t* XI; bf16_t* XO; const float* gate; int row_base;
  __device__ __forceinline__ void operator()(const AccT& acc, const Unit& u, int wr, int wc, int fr, int fq) const {
    const int rowt = row_base + u.pm * 256; const int mi = mod_index(rowt);
    const int row0 = rowt + wr * 64 + fr, col0 = u.pn * 256 + wc * 32 + 8 * fq;
    const float* gp = gate + (size_t)mi * 6144 + col0;
    f32x4 gv[2][2];
#pragma unroll
    for (int bj = 0; bj < 2; ++bj)
#pragma unroll
      for (int n = 0; n < 2; ++n) gv[bj][n] = *(const f32x4*)(gp + bj * 128 + 4 * n);
#pragma unroll
    for (int ai = 0; ai < 2; ++ai)
#pragma unroll
      for (int m = 0; m < 4; ++m) { const int row = row0 + ai * 128 + m * 16;
        const float* xr = FROMX ? ((row < NCTX) ? x0 + (size_t)row * DM : x1 + (size_t)(row - NCTX) * DM) : nullptr;
#pragma unroll
        for (int bj = 0; bj < 2; ++bj) { const int c = col0 + bj * 128;
          f32x4 xa, xb;
          if (FROMX) { xa = *(const f32x4*)(xr + c); xb = *(const f32x4*)(xr + c + 4); }
          else { const u32x4 pv = *(const u32x4*)(XI + (size_t)row * DM + c); xa = (f32x4){lo_bf(pv[0]), hi_bf(pv[0]), lo_bf(pv[1]), hi_bf(pv[1])}; xb = (f32x4){lo_bf(pv[2]), hi_bf(pv[2]), lo_bf(pv[3]), hi_bf(pv[3])}; }
          const f32x4 oa = xa + gv[bj][0] * acc[ai][bj][m][0], ob = xb + gv[bj][1] * acc[ai][bj][m][1];
          u32x4 o; o[0] = cvt_pk_bf16(oa[0], oa[1]); o[1] = cvt_pk_bf16(oa[2], oa[3]); o[2] = cvt_pk_bf16(ob[0], ob[1]); o[3] = cvt_pk_bf16(ob[2], ob[3]);
          *(u32x4*)(XO + (size_t)row * DM + c) = o; } }
  }
};
struct EpiFf2Split {
  static constexpr bool PERM = true;
  const bf16_t* XI; bf16_t* XO; const float* gate; bf16_t* PART; int row_base;
  __device__ __forceinline__ void operator()(const AccT& acc, const Unit& u, int wr, int wc, int fr, int fq) const {
    const int rowl0 = u.pm * 256 + wr * 64 + fr, col0 = u.pn * 256 + wc * 32 + 8 * fq;
    if (u.ks == 0) {
      const float* gp = gate + (size_t)mod_index(row_base + u.pm * 256) * 6144 + col0;
      f32x4 gv[2][2];
#pragma unroll
      for (int bj = 0; bj < 2; ++bj)
#pragma unroll
        for (int n = 0; n < 2; ++n) gv[bj][n] = *(const f32x4*)(gp + bj * 128 + 4 * n);
#pragma unroll
      for (int ai = 0; ai < 2; ++ai)
#pragma unroll
        for (int m = 0; m < 4; ++m) { const size_t ro = (size_t)(row_base + rowl0 + ai * 128 + m * 16) * DM;
#pragma unroll
          for (int bj = 0; bj < 2; ++bj) { const int c = col0 + bj * 128; const u32x4 pv = *(const u32x4*)(XI + ro + c);
            const f32x4 xa = {lo_bf(pv[0]), hi_bf(pv[0]), lo_bf(pv[1]), hi_bf(pv[1])}, xb = {lo_bf(pv[2]), hi_bf(pv[2]), lo_bf(pv[3]), hi_bf(pv[3])};
            const f32x4 oa = xa + gv[bj][0] * acc[ai][bj][m][0], ob = xb + gv[bj][1] * acc[ai][bj][m][1];
            u32x4 o; o[0] = cvt_pk_bf16(oa[0], oa[1]); o[1] = cvt_pk_bf16(oa[2], oa[3]); o[2] = cvt_pk_bf16(ob[0], ob[1]); o[3] = cvt_pk_bf16(ob[2], ob[3]);
            *(u32x4*)(XO + ro + c) = o; } }
    } else {
#pragma unroll
      for (int ai = 0; ai < 2; ++ai)
#pragma unroll
        for (int m = 0; m < 4; ++m) { bf16_t* prow = PART + (size_t)(rowl0 + ai * 128 + m * 16) * DM;
#pragma unroll
          for (int bj = 0; bj < 2; ++bj) { const f32x4 v0 = acc[ai][bj][m][0], v1 = acc[ai][bj][m][1];
            u32x4 o; o[0] = cvt_pk_bf16(v0[0], v0[1]); o[1] = cvt_pk_bf16(v0[2], v0[3]); o[2] = cvt_pk_bf16(v1[0], v1[1]); o[3] = cvt_pk_bf16(v1[2], v1[3]);
            *(u32x4*)(prow + col0 + bj * 128) = o; } }
    }
  }
};
struct EpiFf1 {
  static constexpr bool PERM = true;
  bf16_t* H;
  __device__ __forceinline__ void operator()(const AccT& acc, const Unit& u, int wr, int wc, int fr, int fq) const {
    const int row0 = u.pm * 256 + wr * 64 + fr; const int col0 = u.pn * 256 + wc * 32 + 8 * fq;
    const __amdgpu_buffer_rsrc_t rs = wt_rsrc(H);
#pragma unroll
    for (int ai = 0; ai < 2; ++ai)
#pragma unroll
      for (int m = 0; m < 4; ++m) { bf16_t* rowp = H + (size_t)(row0 + ai * 128 + m * 16) * 4096 + col0;
#pragma unroll
        for (int bj = 0; bj < 2; ++bj) { f32x4 v0 = acc[ai][bj][m][0], v1 = acc[ai][bj][m][1];
#pragma unroll
          for (int j = 0; j < 4; ++j) { const float a = fmaxf(v0[j], 0.f), b = fmaxf(v1[j], 0.f); v0[j] = a * a; v1[j] = b * b; }
          u32x4 o; o[0] = cvt_pk_bf16(v0[0], v0[1]); o[1] = cvt_pk_bf16(v0[2], v0[3]); o[2] = cvt_pk_bf16(v1[0], v1[1]); o[3] = cvt_pk_bf16(v1[2], v1[3]);
          st16_wt(rs, H, rowp + bj * 128, o); } }
  }
};

__device__ __forceinline__ int win_col(int o) {
  if (o < 3072) return o;
  if (o < 4096) return 3456 + (o - 3072);
  if (o < 6144) { const int t = (o - 4096) >> 8, l = (o - 4096) & 255;
    const int bj = l >> 7, wc = (l >> 5) & 3, fq = (l >> 3) & 3, n = (l >> 2) & 1, j = l & 3;
    return (n ? 5504 : 4480) + t * 128 + wc * 32 + fq * 8 + bj * 4 + j; }
  if (o < 6656) { const int l = o - 6144; return l < 384 ? 3072 + l : -1; }
  return 6528 + (o - 6656);
}
template <bool WIN>
__device__ void transpose_job(LAS float* tile, const float* src, int srcN, bf16_t* dst, int O, int K) {
  const int tid = opaque_tid(), nkt = K / 64, ntiles = (O / 64) * nkt;
  for (int tI = blockIdx.x; tI < ntiles; tI += gridDim.x) {
    const int o0 = (tI / nkt) * 64, k0 = (tI % nkt) * 64;
    { const int tx = (tid & 15) * 4, ty = tid >> 4; const int o = o0 + tx; const int c = WIN ? win_col(o) : o;
#pragma unroll
      for (int i = 0; i < 2; ++i) { const int kl = ty + 32 * i; const f32x4 v = (c >= 0) ? *(const f32x4*)(src + (size_t)(k0 + kl) * srcN + c) : (f32x4){0.f, 0.f, 0.f, 0.f};
        tile[kl * 65 + tx] = v[0]; tile[kl * 65 + tx + 1] = v[1]; tile[kl * 65 + tx + 2] = v[2]; tile[kl * 65 + tx + 3] = v[3]; } }
    __syncthreads();
    { const int oy = tid >> 3, kx = (tid & 7) * 8; float v[8];
#pragma unroll
      for (int i = 0; i < 8; ++i) v[i] = tile[(kx + i) * 65 + oy];
      u32x4 o; o[0] = cvt_pk_bf16(v[0], v[1]); o[1] = cvt_pk_bf16(v[2], v[3]); o[2] = cvt_pk_bf16(v[4], v[5]); o[3] = cvt_pk_bf16(v[6], v[7]);
      *(u32x4*)(dst + (size_t)(o0 + oy) * K + k0 + kx) = o; }
    __syncthreads();
  }
}

template <int MODE, bool SRC16 = false>
__device__ void norm_rows(const float* x0, const float* x1, const float* g, const float* mod, int sh_off, int sc_off, bf16_t* dst, float* fout, const bf16_t* src16 = nullptr) {
  const int tid_ = opaque_tid(); const int lane = tid_ & 63, gw = blockIdx.x * 8 + (tid_ >> 6), nw = gridDim.x * 8;
  f32x4 gv[4];
#pragma unroll
  for (int i = 0; i < 4; ++i) gv[i] = *(const f32x4*)(g + i * 256 + lane * 4);
  const int rpw = (NT + gridDim.x - 1) / gridDim.x, rpv = (rpw + 7) / 8;
  const int rbeg = blockIdx.x * rpw + (tid_ >> 6) * rpv, rend = min(min(rbeg + rpv, (int)(blockIdx.x + 1) * rpw), NT);
  int cmi = -1; f32x4 scv[4], shv[4];
#pragma unroll
  for (int i = 0; i < 4; ++i) { scv[i] = (f32x4){0.f, 0.f, 0.f, 0.f}; shv[i] = (f32x4){0.f, 0.f, 0.f, 0.f}; }
  for (int row = rbeg; row < rend; row += 2) {
    const int rowb = (row + 1 < rend) ? (row + 1) : row;
    const float* xa = (row < NCTX) ? x0 + (size_t)row * DM : x1 + (size_t)(row - NCTX) * DM;
    const float* xb = (rowb < NCTX) ? x0 + (size_t)rowb * DM : x1 + (size_t)(rowb - NCTX) * DM;
    f32x4 va[4], vb[4]; float sa = 0.f, sb = 0.f;
    if (SRC16) {
#pragma unroll
      for (int i = 0; i < 4; ++i) { const u32x2 pa = *(const u32x2*)(src16 + (size_t)row * DM + i * 256 + lane * 4), pb = *(const u32x2*)(src16 + (size_t)rowb * DM + i * 256 + lane * 4);
        va[i] = (f32x4){lo_bf(pa[0]), hi_bf(pa[0]), lo_bf(pa[1]), hi_bf(pa[1])}; vb[i] = (f32x4){lo_bf(pb[0]), hi_bf(pb[0]), lo_bf(pb[1]), hi_bf(pb[1])}; }
    } else {
#pragma unroll
      for (int i = 0; i < 4; ++i) { va[i] = *(const f32x4*)(xa + i * 256 + lane * 4); vb[i] = *(const f32x4*)(xb + i * 256 + lane * 4); }
    }
    if (MODE == 1) {
      if (row >= 16384) { const float* gp = mod + (size_t)mod_index(row) * 6144 + sh_off; const bf16_t* pp = dst + (size_t)(row - 16384) * DM;
#pragma unroll
        for (int i = 0; i < 4; ++i) { const int cc = i * 256 + lane * 4; const u32x2 pv = *(const u32x2*)(pp + cc); const f32x4 gt = *(const f32x4*)(gp + cc);
          va[i][0] += gt[0] * lo_bf(pv[0]); va[i][1] += gt[1] * hi_bf(pv[0]); va[i][2] += gt[2] * lo_bf(pv[1]); va[i][3] += gt[3] * hi_bf(pv[1]); } }
      if (rowb >= 16384) { const float* gp = mod + (size_t)mod_index(rowb) * 6144 + sh_off; const bf16_t* pp = dst + (size_t)(rowb - 16384) * DM;
#pragma unroll
        for (int i = 0; i < 4; ++i) { const int cc = i * 256 + lane * 4; const u32x2 pv = *(const u32x2*)(pp + cc); const f32x4 gt = *(const f32x4*)(gp + cc);
          vb[i][0] += gt[0] * lo_bf(pv[0]); vb[i][1] += gt[1] * hi_bf(pv[0]); vb[i][2] += gt[2] * lo_bf(pv[1]); vb[i][3] += gt[3] * hi_bf(pv[1]); } }
    }
#pragma unroll
    for (int i = 0; i < 4; ++i) { sa += va[i][0] * va[i][0] + va[i][1] * va[i][1] + va[i][2] * va[i][2] + va[i][3] * va[i][3];
                                  sb += vb[i][0] * vb[i][0] + vb[i][1] * vb[i][1] + vb[i][2] * vb[i][2] + vb[i][3] * vb[i][3]; }
    sa = wave_sum(sa); sb = wave_sum(sb);
    const float ra = rsqrtf(sa * (1.0f / 1024.0f) + 1e-6f), rb = rsqrtf(sb * (1.0f / 1024.0f) + 1e-6f);
    if (MODE == 0) {
      const int mia = mod_index(row), mib = mod_index(rowb);
      if (mia != cmi) { cmi = mia; const float* ma = mod + (size_t)mia * 6144;
#pragma unroll
        for (int i = 0; i < 4; ++i) { scv[i] = *(const f32x4*)(ma + sc_off + i * 256 + lane * 4) + 1.0f; shv[i] = *(const f32x4*)(ma + sh_off + i * 256 + lane * 4); } }
      f32x4 scb[4], shb[4];
#pragma unroll
      for (int i = 0; i < 4; ++i) { scb[i] = scv[i]; shb[i] = shv[i]; }
      if (mib != mia) { const float* mb = mod + (size_t)mib * 6144;
#pragma unroll
        for (int i = 0; i < 4; ++i) { scb[i] = *(const f32x4*)(mb + sc_off + i * 256 + lane * 4) + 1.0f; shb[i] = *(const f32x4*)(mb + sh_off + i * 256 + lane * 4); } }
#pragma unroll
      for (int i = 0; i < 4; ++i) { const int cc = i * 256 + lane * 4;
        const f32x4 oa = va[i] * ra * gv[i] * scv[i] + shv[i], ob = vb[i] * rb * gv[i] * scb[i] + shb[i];
        u32x2 pa, pb; pa[0] = cvt_pk_bf16(oa[0], oa[1]); pa[1] = cvt_pk_bf16(oa[2], oa[3]); pb[0] = cvt_pk_bf16(ob[0], ob[1]); pb[1] = cvt_pk_bf16(ob[2], ob[3]);
        *(u32x2*)(dst + (size_t)row * DM + cc) = pa; if (rowb != row) *(u32x2*)(dst + (size_t)rowb * DM + cc) = pb; }
    } else {
#pragma unroll
      for (int i = 0; i < 4; ++i) { const int cc = i * 256 + lane * 4;
        *(f32x4*)(fout + (size_t)row * DM + cc) = va[i] * ra * gv[i]; if (rowb != row) *(f32x4*)(fout + (size_t)rowb * DM + cc) = vb[i] * rb * gv[i]; }
    }
  }
}

__device__ __forceinline__ unsigned cvt_pk_bf16_p(float lo, float hi) { return cvt_pk_bf16(lo, hi); }
__device__ __forceinline__ float fsigmoid(float x) { return __builtin_amdgcn_rcpf(1.0f + __expf(-x)); }
constexpr int AVP = 136;
constexpr int KBP = 1040, VVP = 528;
constexpr int SC_AV = 0, SC_KB = 128 * AVP, SC_WW = SC_KB + 16 * KBP, SC_VV = SC_WW + 4096, SC_CC = SC_VV + 16 * VVP, SC_BUFB = SC_CC + 2048;
constexpr int SC_YB = 2 * SC_BUFB;
constexpr int GSP = 32 * AVP;
constexpr int SC_GS = SC_YB + 16640;
constexpr int SC_WT = SC_GS + 4 * GSP;
constexpr int SC_CT = SC_WT + 2 * 64 * 144;
constexpr int SC_END = SC_CT + 1280;
struct CSetP { u32x4 A0, A1, A2, A3; };
struct PLoad { bf16x8 a00, a01, a10, a11; u32x2 k[4], r[4]; };
template <int DIR>
__device__ void scan_unit(const Params& p, LAS unsigned char* lds, int h, int half, int tb0, int n0, const float* s0,
                          int tb1, int tbstride, int n1, int nseg1, float* so1, size_t sostride, bf16_t* ydst, bool bgconv) {
  constexpr int dir = DIR;
  const int tid = opaque_tid(), lane = tid & 63, wid = __builtin_amdgcn_readfirstlane(tid >> 6);
  const int c = lane & 15, q = lane >> 4;
  const int nch = n0 + n1 * nseg1;
#define SC_TB(g_) (((g_) < n0) ? (tb0 + (DIR ? (n0 - 1 - (g_)) : (g_)) * 64) \
                               : (tb1 + (((g_) - n0) / n1) * tbstride + (DIR ? (n1 - 1 - (((g_) - n0) % n1)) : (((g_) - n0) % n1)) * 64))
  if (wid < 2) {
    __builtin_amdgcn_s_setprio(3);
    const int rowl = wid * 16 + c, rg = half * 32 + rowl;
    f32x4 acc0, acc1, acc2, acc3;
    if (s0 && n0 > 0) { const float* sp = s0 + rg * 64 + 4 * q; acc0 = *(const f32x4*)(sp); acc1 = *(const f32x4*)(sp + 16); acc2 = *(const f32x4*)(sp + 32); acc3 = *(const f32x4*)(sp + 48); }
    else { acc0 = acc1 = acc2 = acc3 = (f32x4){0.f, 0.f, 0.f, 0.f}; }
    CSetP SA, SB;
    for (int ci = 0; ci < nch; ++ci) {
      __syncthreads();
      if (ci >= n0 && ci > 0 && ((ci - n0) % n1) == 0) acc0 = acc1 = acc2 = acc3 = (f32x4){0.f, 0.f, 0.f, 0.f};
      LAS unsigned char* B = lds + (ci & 1) * SC_BUFB;
      LAS float* yb = (LAS float*)(lds + SC_YB) + (ci & 1) * (32 * 65) + rowl * 65;
      LAS unsigned char* pA = B + SC_AV + (c & 3) * AVP + 8 * q;
      LAS unsigned char* pW = B + SC_WW + 16 * q;
      LAS unsigned char* pK = B + SC_KB + 16 * c;
      LAS unsigned char* pV = B + SC_VV + 16 * rowl;
      LAS unsigned char* pC = B + SC_CC;
      LAS unsigned char* pE = B + SC_CC + 512 + (c & 3) * 8;
      LAS unsigned char* pY = B + SC_CC + 1024 + (c & 3) * 16;
#define SC_RL(s_) (DIR ? (15 - (s_)) : (s_))
#define SC_LDP(o, rl_) do { const int _r = (rl_) * (8 * AVP); \
      { const u32x2 _x0 = *(const LAS u32x2*)(pA + _r), _x1 = *(const LAS u32x2*)(pA + _r + 32), _x2 = *(const LAS u32x2*)(pA + _r + 64), _x3 = *(const LAS u32x2*)(pA + _r + 96); \
        const u32x2 _x4 = *(const LAS u32x2*)(pA + _r + 4 * AVP), _x5 = *(const LAS u32x2*)(pA + _r + 4 * AVP + 32), _x6 = *(const LAS u32x2*)(pA + _r + 4 * AVP + 64), _x7 = *(const LAS u32x2*)(pA + _r + 4 * AVP + 96); \
        o.A0[0] = _x0[0]; o.A0[1] = _x0[1]; o.A0[2] = _x1[0]; o.A0[3] = _x1[1]; o.A1[0] = _x2[0]; o.A1[1] = _x2[1]; o.A1[2] = _x3[0]; o.A1[3] = _x3[1]; \
        o.A2[0] = _x4[0]; o.A2[1] = _x4[1]; o.A2[2] = _x5[0]; o.A2[3] = _x5[1]; o.A3[0] = _x6[0]; o.A3[1] = _x6[1]; o.A3[2] = _x7[0]; o.A3[3] = _x7[1]; } } while (0)
#define SC_ROUND(C, N, ri_, rnx_) do { const int _rl = SC_RL(ri_); \
      SC_LDP(N, SC_RL(rnx_)); \
      const u32x4 K0 = *(const LAS u32x4*)(pK + _rl * KBP), K1 = *(const LAS u32x4*)(pK + _rl * KBP + 256), K2 = *(const LAS u32x4*)(pK + _rl * KBP + 512), K3 = *(const LAS u32x4*)(pK + _rl * KBP + 768); \
      const f32x4 vv = *(const LAS f32x4*)(pV + _rl * VVP); \
      const f32x4 e2a = *(const LAS f32x4*)(pC + _rl * 32), e2b = *(const LAS f32x4*)(pC + _rl * 32 + 16); \
      const u32x2 eva = *(const LAS u32x2*)(pE + _rl * 32); const u32x4 evy = *(const LAS u32x4*)(pY + _rl * 64); \
      asm volatile("" ::: "memory"); \
        \
      u32x4 b0, b1; \
      b0[0] = cvt_pk_bf16_p(acc0[0], acc0[1]); b0[1] = cvt_pk_bf16_p(acc0[2], acc0[3]); b0[2] = cvt_pk_bf16_p(acc1[0], acc1[1]); b0[3] = cvt_pk_bf16_p(acc1[2], acc1[3]); \
      const f32x4 zz = {0.f, 0.f, 0.f, 0.f}; \
      f32x4 dA = __builtin_amdgcn_mfma_f32_16x16x32_bf16(__builtin_bit_cast(bf16x8, C.A0), __builtin_bit_cast(bf16x8, b0), zz, 0, 0, 0); \
      f32x4 dB = __builtin_amdgcn_mfma_f32_16x16x32_bf16(__builtin_bit_cast(bf16x8, C.A2), __builtin_bit_cast(bf16x8, b0), zz, 0, 0, 0); \
      b1[0] = cvt_pk_bf16_p(acc2[0], acc2[1]); b1[1] = cvt_pk_bf16_p(acc2[2], acc2[3]); b1[2] = cvt_pk_bf16_p(acc3[0], acc3[1]); b1[3] = cvt_pk_bf16_p(acc3[2], acc3[3]); \
      dA = __builtin_amdgcn_mfma_f32_16x16x32_bf16(__builtin_bit_cast(bf16x8, C.A1), __builtin_bit_cast(bf16x8, b1), dA, 0, 0, 0); \
      dB = __builtin_amdgcn_mfma_f32_16x16x32_bf16(__builtin_bit_cast(bf16x8, C.A3), __builtin_bit_cast(bf16x8, b1), dB, 0, 0, 0); \
      const float v1 = vv[0], v2 = vv[1], v3 = vv[2], v4 = vv[3]; \
      { const unsigned be0 = cvt_pk_bf16_p(v1, v2), be1 = cvt_pk_bf16_p(v3, v4); \
        const u32x4 bev = {(q == 0) ? be0 : 0u, (q == 0) ? be1 : 0u, 0u, 0u}; const u32x4 ae0 = {eva[0], eva[1], 0u, 0u}; \
          \
        dA = __builtin_amdgcn_mfma_f32_16x16x32_bf16(__builtin_bit_cast(bf16x8, ae0), __builtin_bit_cast(bf16x8, bev), dA, 0, 0, 0); } \
      const float psa1 = dA[0]; \
      const float psa2 = dA[1] + psa1 * e2a[0];     \
      const float psa3 = dA[2] + psa1 * e2a[1] + psa2 * e2a[2]; \
      const float psa4 = dA[3] + psa1 * e2a[3] + psa2 * e2b[0] + psa3 * e2b[1]; \
      u32x4 bbv; \
      { const unsigned bd1 = cvt_pk_bf16_p(v1, psa1), bd2 = cvt_pk_bf16_p(v2, psa2), bd3 = cvt_pk_bf16_p(v3, psa3), bd4 = cvt_pk_bf16_p(v4, psa4);     \
        bbv[0] = (q == 0) ? bd1 : 0u; bbv[1] = (q == 0) ? bd2 : 0u; bbv[2] = (q == 0) ? bd3 : 0u; bbv[3] = (q == 0) ? bd4 : 0u; } \
      const bf16x8 bb = __builtin_bit_cast(bf16x8, bbv); \
        \
      dB = __builtin_amdgcn_mfma_f32_16x16x32_bf16(__builtin_bit_cast(bf16x8, evy), bb, dB, 0, 0, 0); \
      acc0 = __builtin_amdgcn_mfma_f32_16x16x32_bf16(__builtin_bit_cast(bf16x8, K0), bb, acc0, 0, 0, 0); \
      acc1 = __builtin_amdgcn_mfma_f32_16x16x32_bf16(__builtin_bit_cast(bf16x8, K1), bb, acc1, 0, 0, 0); \
      acc2 = __builtin_amdgcn_mfma_f32_16x16x32_bf16(__builtin_bit_cast(bf16x8, K2), bb, acc2, 0, 0, 0); \
      acc3 = __builtin_amdgcn_mfma_f32_16x16x32_bf16(__builtin_bit_cast(bf16x8, K3), bb, acc3, 0, 0, 0); \
      { const float ya = (q & 1) ? dB[1] : dB[0], ybv = (q & 1) ? dB[3] : dB[2]; yb[DIR ? (4 * _rl + 3 - q) : (4 * _rl + q)] = (q & 2) ? ybv : ya; } \
      asm volatile("" ::: "memory"); __builtin_amdgcn_sched_barrier(0); } while (0)
      SC_LDP(SA, SC_RL(0));
      for (int g = 0; g < 8; ++g) {
        const int r0 = g * 2; const int rlast = (r0 + 2 < 16) ? (r0 + 2) : 15;
        f32x4 wt0, wt1, wt2, wt3;
        if (g & 1) { const int tl = SC_RL(r0) >> 2;
          wt0 = *(const LAS f32x4*)(pW + tl * 256); wt1 = *(const LAS f32x4*)(pW + tl * 256 + 64); wt2 = *(const LAS f32x4*)(pW + tl * 256 + 128); wt3 = *(const LAS f32x4*)(pW + tl * 256 + 192); }
        SC_ROUND(SA, SB, r0, r0 + 1);
        SC_ROUND(SB, SA, r0 + 1, rlast);
        if (g & 1) { acc0 *= wt0; acc1 *= wt1; acc2 *= wt2; acc3 *= wt3; }
      }
      if (ci >= n0 && ((ci - n0) % n1) == n1 - 1) {
        float* sp = so1 + (size_t)((ci - n0) / n1) * sostride + rg * 64 + 4 * q; *(f32x4*)(sp) = acc0; *(f32x4*)(sp + 16) = acc1; *(f32x4*)(sp + 32) = acc2; *(f32x4*)(sp + 48) = acc3; }
    }
    __syncthreads();
    __builtin_amdgcn_s_setprio(0);
#undef SC_LDP
#undef SC_ROUND
#undef SC_RL
  } else if (wid == 4 || wid == 5) {
    const int L = (wid - 4) * 64 + lane, ft = L >> 1, rh = L & 1;
    const bf16_t* Uq = (const bf16_t*)(p.ws + WS_U); bf16_t* CBq = (bf16_t*)(p.ws + WS_CB);
    float cw0[8], cw1[8], cw2[8];
    if (bgconv) {
#pragma unroll
      for (int i = 0; i < 8; ++i) { cw0[i] = p.in[21][L * 8 + i]; cw1[i] = p.in[21][1024 + L * 8 + i]; cw2[i] = p.in[21][2048 + L * 8 + i]; } }
    LAS float* tsc = (LAS float*)(lds + SC_TT) + (wid - 4) * 1056;
    const bf16_t* Vq = (const bf16_t*)(p.ws + WS_V);
#define FL_VVFILL(g_) do { const int _tb = SC_TB(g_); LAS unsigned char* _B = lds + ((g_) & 1) * SC_BUFB; const int _tl = L >> 1, _rh = L & 1; \
      const bf16_t* _vp = Vq + (size_t)(_tb + _tl) * DM + h * 64 + half * 32 + _rh * 16; const u32x4 _v0 = *(const u32x4*)(_vp), _v1 = *(const u32x4*)(_vp + 8); \
      const int _js = DIR ? (3 - (_tl & 3)) : (_tl & 3); LAS unsigned char* _wp = _B + SC_VV + (_tl >> 2) * VVP + ((_rh * 16) * 4 + _js) * 4; \
      _Pragma("unroll") for (int i = 0; i < 4; ++i) { *(LAS float*)(_wp + (2 * i) * 16) = lo_bf(_v0[i]); *(LAS float*)(_wp + (2 * i + 1) * 16) = hi_bf(_v0[i]); \
        *(LAS float*)(_wp + (8 + 2 * i) * 16) = lo_bf(_v1[i]); *(LAS float*)(_wp + (8 + 2 * i + 1) * 16) = hi_bf(_v1[i]); } } while (0)
    if (nch > 0) FL_VVFILL(0);
    for (int ci = 0; ci <= nch; ++ci) {
      __syncthreads();
      if (ci + 1 < nch) FL_VVFILL(ci + 1);
#define BG_TRANSPOSE(src_, srcN_, dst_, Kd_, jt_) do { const int _nkt = (Kd_) / 32; const int _o0 = ((jt_) / _nkt) * 32, _k0 = ((jt_) % _nkt) * 32; \
        { const int kr = lane >> 3, oc = (lane & 7) * 4; \
          _Pragma("unroll") for (int pz = 0; pz < 4; ++pz) { const f32x4 v = *(const f32x4*)((src_) + (size_t)(_k0 + kr + 8 * pz) * (srcN_) + _o0 + oc); \
            LAS float* tp = tsc + (kr + 8 * pz) * 33 + oc; tp[0] = v[0]; tp[1] = v[1]; tp[2] = v[2]; tp[3] = v[3]; } } \
        { const int oo = lane & 31, kh = lane >> 5; float w[16]; \
          _Pragma("unroll") for (int i = 0; i < 16; ++i) w[i] = tsc[(kh * 16 + i) * 33 + oo]; \
          u32x4 a, b2; \
          _Pragma("unroll") for (int i = 0; i < 4; ++i) { a[i] = cvt_pk_bf16(w[2 * i], w[2 * i + 1]); b2[i] = cvt_pk_bf16(w[8 + 2 * i], w[8 + 2 * i + 1]); } \
          bf16_t* dp = (dst_) + (size_t)(_o0 + oo) * (Kd_) + _k0 + kh * 16; *(u32x4*)(dp) = a; *(u32x4*)(dp + 8) = b2; } } while (0)
      if (bgconv && ci < 80 && (ci % 5) == 0) {
        const int job = (blockIdx.x * 2 + (wid - 4)) * 16 + ci / 5;
        const bool second = job >= 4096; const int jt = second ? job - 4096 : job;
        const float* src = second ? p.in[26] : p.in[25]; const int srcN = second ? 1024 : 4096, Kd = second ? 4096 : 1024;
        bf16_t* dstw = (bf16_t*)(p.ws + (second ? WS_WFF2 : WS_WFF1));
        BG_TRANSPOSE(src, srcN, dstw, Kd, jt);
      }
      if (bgconv && ci < 35 && (ci % 5) == 2) {
        const int job = (blockIdx.x * 2 + (wid - 4)) * 7 + ci / 5;
        if (job < 3072) { const int which = job >> 10, jt = job & 1023;
          const float* src = (which == 0) ? p.in[22] : (which == 1) ? p.in[23] : p.in[24];
          bf16_t* dstw = (bf16_t*)(p.ws + WS_WPA) + (size_t)which * 1024 * 1024;
          BG_TRANSPOSE(src, 1024, dstw, 1024, jt);
        } else if (job < 3200) { const int jt = job - 3072;
          BG_TRANSPOSE(p.in[15], 1024, (bf16_t*)(p.ws + WS_G2T), 128, jt); }
      }
#undef BG_TRANSPOSE
      if (bgconv && ci < 80) {
        const int tok = blockIdx.x * 80 + ci; const int Wm = (tok < NCTX) ? 255 : 63; const int pos = tok & Wm;
        const size_t off = (size_t)tok * DM + L * 8;
        const u32x4 uc = *(const u32x4*)(Uq + off), cbv = *(const u32x4*)(CBq + off);
        u32x4 up = {0u, 0u, 0u, 0u}, un = {0u, 0u, 0u, 0u};
        if (pos != 0) up = *(const u32x4*)(Uq + off - DM);
        if (pos != Wm) un = *(const u32x4*)(Uq + off + DM);
        float o[8];
#pragma unroll
        for (int i = 0; i < 4; ++i) {
          o[2 * i] = lo_bf(cbv[i]) * (cw0[2 * i] * lo_bf(up[i]) + cw1[2 * i] * lo_bf(uc[i]) + cw2[2 * i] * lo_bf(un[i]));
          o[2 * i + 1] = hi_bf(cbv[i]) * (cw0[2 * i + 1] * hi_bf(up[i]) + cw1[2 * i + 1] * hi_bf(uc[i]) + cw2[2 * i + 1] * hi_bf(un[i]));
        }
        u32x4 ob; ob[0] = cvt_pk_bf16(o[0], o[1]); ob[1] = cvt_pk_bf16(o[2], o[3]); ob[2] = cvt_pk_bf16(o[4], o[5]); ob[3] = cvt_pk_bf16(o[6], o[7]);
        *(u32x4*)(CBq + off) = ob;
      }
      if (ci >= 1) {
        const int cj = ci - 1, tb = SC_TB(cj);
        const LAS float* yb = (const LAS float*)(lds + SC_YB) + (cj & 1) * (32 * 65) + (rh * 16) * 65 + ft;
        float yv[16];
#pragma unroll
        for (int i = 0; i < 16; ++i) yv[i] = yb[i * 65];
        u32x4 o0, o1;
#pragma unroll
        for (int i = 0; i < 4; ++i) { o0[i] = cvt_pk_bf16(yv[2 * i], yv[2 * i + 1]); o1[i] = cvt_pk_bf16(yv[8 + 2 * i], yv[8 + 2 * i + 1]); }
        bf16_t* dp = ydst + (size_t)(tb + ft) * DM + h * 64 + half * 32 + rh * 16;
        *(u32x4*)(dp) = o0; *(u32x4*)(dp + 8) = o1;
      }
    }
  } else {
    const int pw = (wid & 1) + ((wid >> 2) << 1), t0 = pw * 16;
    const bf16_t* Rr = (const bf16_t*)(p.ws + WS_R); const bf16_t* Kr = (const bf16_t*)(p.ws + WS_K); const bf16_t* Vr = (const bf16_t*)(p.ws + WS_V);
    const bf16_t* LOR = (const bf16_t*)(p.ws + WS_LOR);
    float* C3 = (float*)(p.ws + WS_C3);
    LAS float* CT = (LAS float*)(lds + SC_CT);
    LAS unsigned char* WT = lds + SC_WT;
    LAS unsigned char* GS = lds + SC_GS + pw * GSP;
    { const int ch = h * 64 + lane;
      CT[lane] = p.in[11][dir * 1024 + ch]; CT[64 + lane] = p.in[13][dir * 1024 + ch]; CT[128 + lane] = p.in[16][ch]; CT[192 + lane] = p.in[17][ch]; CT[256 + lane] = p.in[18][ch];
#pragma unroll 2
      for (int i = 0; i < 16; ++i) { const int e = i * 64 + lane; const int sel = e >> 9, row = (e >> 3) & 63, seg = e & 7;
        const u32x4 wv = *(const u32x4*)((const bf16_t*)(p.ws + (sel ? WS_A2T : WS_W2T)) + ((size_t)(dir * 1024 + h * 64 + row)) * 64 + seg * 8);
        *(LAS u32x4*)(WT + (sel * 64 + row) * 144 + seg * 16) = wv; } }
    const int js = DIR ? (3 - (c & 3)) : (c & 3);
#define SC_PLD_A(o, ci_) do { const size_t _tok = (size_t)(SC_TB(ci_) + t0 + c); \
      const bf16_t* _ap = LOR + _tok * 384 + dir * 64 + q * 8; \
      o.a00 = *(const bf16x8*)(_ap); o.a01 = *(const bf16x8*)(_ap + 32); o.a10 = *(const bf16x8*)(_ap + 128); o.a11 = *(const bf16x8*)(_ap + 160); } while (0)
#define SC_PLD_K(o, ci_) do { const size_t _tok = (size_t)(SC_TB(ci_) + t0 + c); \
      const size_t _to = _tok * DM + h * 64; \
      _Pragma("unroll") for (int nt = 0; nt < 4; ++nt) { o.k[nt] = *(const u32x2*)(Kr + _to + nt * 16 + 4 * q); o.r[nt] = *(const u32x2*)(Rr + _to + nt * 16 + 4 * q); } } while (0)
    PLoad cur; SC_PLD_A(cur, 0); SC_PLD_K(cur, 0);
    for (int ci = 0; ci < nch; ++ci) {
      const int tb = SC_TB(ci);
      LAS unsigned char* B = lds + (ci & 1) * SC_BUFB;
      const int cn = (ci + 1 < nch) ? (ci + 1) : ci;
      const int t = t0 + c, rho = t >> 2;
      float ss = 0.f, c1 = 0.f, c2 = 0.f, c3 = 0.f;
      f32x4 decr[4], avr[4], kkr4[4], kdr4[4], rfr4[4];
#pragma unroll
      for (int nt = 0; nt < 4; ++nt) {
        const bf16x8 w0f = *(const LAS bf16x8*)(WT + (nt * 16 + c) * 144 + q * 16), w1f = *(const LAS bf16x8*)(WT + (nt * 16 + c) * 144 + 64 + q * 16);
        const bf16x8 a0f = *(const LAS bf16x8*)(WT + (64 + nt * 16 + c) * 144 + q * 16), a1f = *(const LAS bf16x8*)(WT + (64 + nt * 16 + c) * 144 + 64 + q * 16);
        f32x4 X = {0.f, 0.f, 0.f, 0.f}, Y = {0.f, 0.f, 0.f, 0.f};
        X = __builtin_amdgcn_mfma_f32_16x16x32_bf16(w0f, cur.a00, X, 0, 0, 0); X = __builtin_amdgcn_mfma_f32_16x16x32_bf16(w1f, cur.a01, X, 0, 0, 0);
        Y = __builtin_amdgcn_mfma_f32_16x16x32_bf16(a0f, cur.a10, Y, 0, 0, 0); Y = __builtin_amdgcn_mfma_f32_16x16x32_bf16(a1f, cur.a11, Y, 0, 0, 0);
        const int kb = nt * 16 + 4 * q;
        const f32x4 tw0 = *(const LAS f32x4*)(CT + kb), ta0 = *(const LAS f32x4*)(CT + 64 + kb), tkk = *(const LAS f32x4*)(CT + 128 + kb), tka = *(const LAS f32x4*)(CT + 192 + kb), trk = *(const LAS f32x4*)(CT + 256 + kb);
        const float kf[4] = {lo_bf(cur.k[nt][0]), hi_bf(cur.k[nt][0]), lo_bf(cur.k[nt][1]), hi_bf(cur.k[nt][1])};
        const float rf[4] = {lo_bf(cur.r[nt][0]), hi_bf(cur.r[nt][0]), lo_bf(cur.r[nt][1]), hi_bf(cur.r[nt][1])};
#pragma unroll
        for (int j = 0; j < 4; ++j) {
          decr[nt][j] = __expf(-0.6065306597126334f * fsigmoid(tw0[j] + X[j]));
          const float av = fsigmoid(ta0[j] + Y[j]); avr[nt][j] = av;
          const float kr_ = kf[j] * tkk[j]; ss += kr_ * kr_;
          const float kd = kf[j] * (1.0f + (av - 1.0f) * tka[j]);
          kkr4[nt][j] = kr_; kdr4[nt][j] = kd; rfr4[nt][j] = rf[j];
          c1 += kd * rf[j]; c3 += rf[j] * kd * trk[j];
        }
      }
      SC_PLD_A(cur, cn);
      ss += __shfl_xor(ss, 16); ss += __shfl_xor(ss, 32);
      const float inv = rsqrtf(fmaxf(ss, 1e-12f));
#pragma unroll
      for (int nt = 0; nt < 4; ++nt) {
        const int kb = nt * 16 + 4 * q;
        const f32x4 rf = rfr4[nt];
        float kkt[4], wrt[4], kdt[4], bt[4]; f32x4 pin;
#pragma unroll
        for (int j = 0; j < 4; ++j) {
          const float dec = decr[nt][j], av = avr[nt][j];
          const float kk = kkr4[nt][j] * inv, bv = -(kk * av), kd = kdr4[nt][j];
          c2 += bv * rf[j];
          float Pin = dec;
          Pin *= DIR ? dppo<0x101>(1.0f, Pin) : dppo<0x111>(1.0f, Pin);
          Pin *= DIR ? dppo<0x102>(1.0f, Pin) : dppo<0x112>(1.0f, Pin);
          Pin *= DIR ? dppo<0x104>(1.0f, Pin) : dppo<0x114>(1.0f, Pin);
          Pin *= DIR ? dppo<0x108>(1.0f, Pin) : dppo<0x118>(1.0f, Pin);
          const float Pex = DIR ? dppo<0x101>(1.0f, Pin) : dppo<0x111>(1.0f, Pin);
          const float rP = __builtin_amdgcn_rcpf(Pin);
          kkt[j] = kk * Pex; wrt[j] = rf[j] * Pin; kdt[j] = kd * rP; bt[j] = bv * rP; pin[j] = Pin;
          *(LAS unsigned*)(B + SC_KB + rho * KBP + ((kb + j) * 4 + js) * 4) = cvt_pk_bf16(kdt[j], bt[j]);
        }
        { u32x2 o; o[0] = cvt_pk_bf16(kkt[0], kkt[1]); o[1] = cvt_pk_bf16(kkt[2], kkt[3]); *(LAS u32x2*)(B + SC_AV + (rho * 8 + js) * AVP + kb * 2) = o; }
        { u32x2 o; o[0] = cvt_pk_bf16(wrt[0], wrt[1]); o[1] = cvt_pk_bf16(wrt[2], wrt[3]); *(LAS u32x2*)(B + SC_AV + (rho * 8 + 4 + js) * AVP + kb * 2) = o; }
        { u32x2 o; o[0] = cvt_pk_bf16(kdt[0], kdt[1]); o[1] = cvt_pk_bf16(kdt[2], kdt[3]); *(LAS u32x2*)(GS + (c * 2 + 0) * AVP + kb * 2) = o; }
        { u32x2 o; o[0] = cvt_pk_bf16(bt[0], bt[1]); o[1] = cvt_pk_bf16(bt[2], bt[3]); *(LAS u32x2*)(GS + (c * 2 + 1) * AVP + kb * 2) = o; }
        if ((DIR ? (15 - c) : c) == 15) *(LAS f32x4*)(B + SC_WW + (pw * 64 + kb) * 4) = pin;
      }
      c1 += __shfl_xor(c1, 16); c1 += __shfl_xor(c1, 32); c2 += __shfl_xor(c2, 16); c2 += __shfl_xor(c2, 32); c3 += __shfl_xor(c3, 16); c3 += __shfl_xor(c3, 32);
      LAS float* cp = (LAS float*)(B + SC_CC + rho * 32);
      LAS unsigned short* eva = (LAS unsigned short*)(B + SC_CC + 512 + rho * 32);
      LAS unsigned short* evy = (LAS unsigned short*)(B + SC_CC + 1024 + rho * 64);
      if (q == 0 && half == 0) C3[((size_t)dir * NT + tb + t) * 16 + h] = c3;
      { const LAS unsigned char* ap = B + SC_AV + (rho * 8 + js) * AVP + 16 * q;
        const LAS unsigned char* gp = GS + (c * 2) * AVP + 16 * q;
#define SC_LD16(p_) ({ const u32x2 _a = *(const LAS u32x2*)(p_), _b = *(const LAS u32x2*)((p_) + 8); const u32x4 _v = {_a[0], _a[1], _b[0], _b[1]}; __builtin_bit_cast(bf16x8, _v); })
        const bf16x8 akk0 = SC_LD16(ap), akk1 = SC_LD16(ap + 64), awr0 = SC_LD16(ap + 4 * AVP), awr1 = SC_LD16(ap + 4 * AVP + 64);
        const bf16x8 bkd0 = SC_LD16(gp), bkd1 = SC_LD16(gp + 64), bb0 = SC_LD16(gp + AVP), bb1 = SC_LD16(gp + AVP + 64);
#undef SC_LD16
        const f32x4 zz = {0.f, 0.f, 0.f, 0.f};
        f32x4 gE1 = __builtin_amdgcn_mfma_f32_16x16x32_bf16(akk0, bkd0, zz, 0, 0, 0); gE1 = __builtin_amdgcn_mfma_f32_16x16x32_bf16(akk1, bkd1, gE1, 0, 0, 0);
        f32x4 gE2 = __builtin_amdgcn_mfma_f32_16x16x32_bf16(akk0, bb0, zz, 0, 0, 0);  gE2 = __builtin_amdgcn_mfma_f32_16x16x32_bf16(akk1, bb1, gE2, 0, 0, 0);
        f32x4 gF1 = __builtin_amdgcn_mfma_f32_16x16x32_bf16(awr0, bkd0, zz, 0, 0, 0); gF1 = __builtin_amdgcn_mfma_f32_16x16x32_bf16(awr1, bkd1, gF1, 0, 0, 0);
        f32x4 gF2 = __builtin_amdgcn_mfma_f32_16x16x32_bf16(awr0, bb0, zz, 0, 0, 0);  gF2 = __builtin_amdgcn_mfma_f32_16x16x32_bf16(awr1, bb1, gF2, 0, 0, 0);
        if (q == (c >> 2)) {
#pragma unroll
          for (int jj = 0; jj < 4; ++jj) { const int jsj = DIR ? (3 - jj) : jj;
            const float eE = (jsj > js) ? gE1[jj] : 0.f;
            const float eFv = (jsj > js) ? gF1[jj] : ((jsj == js) ? c1 : 0.f);
            const float eFp = (jsj > js) ? gF2[jj] : ((jsj == js) ? c2 : 0.f);
            eva[jsj * 4 + js] = (unsigned short)(cvt_pk_bf16(eE, 0.f) & 0xffffu);
            *(LAS unsigned*)(evy + jsj * 8 + 2 * js) = cvt_pk_bf16(eFv, eFp);
            if (jsj > js) { const int idx = jsj * (jsj - 1) / 2 + js; cp[idx] = gE2[jj]; } }
        }
      }
      SC_PLD_K(cur, cn);
      __syncthreads();
    }
    __syncthreads();
#undef SC_PLD_A
#undef SC_PLD_K
  }
  __syncthreads();
#undef SC_TB
}

#define XB_TMO      128
#define XB_XCNT(j)  (256  + 64 * (j))
#define XB_XSUB(j)  (1280 + 64 * (j))
#define XB_XGEN(j)  (2304 + 64 * (j))
#define XB_TOP      3328
#define XB_TOPGEN   3392
#define XCD_BAR_WORDS 3456
#define XB_SPIN_CAP (1u << 18)
__device__ __forceinline__ unsigned xb_ld(unsigned* p)              { return __hip_atomic_load(p, __ATOMIC_RELAXED, __HIP_MEMORY_SCOPE_AGENT); }
__device__ __forceinline__ unsigned xb_add(unsigned* p, unsigned v) { return __hip_atomic_fetch_add(p, v, __ATOMIC_RELAXED, __HIP_MEMORY_SCOPE_AGENT); }
__device__ __forceinline__ unsigned xb_xcc_id() { return (unsigned)__builtin_amdgcn_s_getreg((3 << 11) | 20) & 0xFu; }
#define XB_SPIN(cond, bar) do { unsigned _sp = 0; while (cond) { __builtin_amdgcn_s_sleep(1); \
    if ((++_sp & 255u) == 0u) { if (xb_ld(&(bar)[XB_TMO])) break; if (_sp > XB_SPIN_CAP) { atomicAdd(&(bar)[XB_TMO], 1u); break; } } } } while (0)
struct XcdBarrier { unsigned* bar; unsigned x; volatile LAS unsigned* st; };
__device__ __forceinline__ XcdBarrier xcd_barrier_post(unsigned* bar, volatile LAS unsigned* st) {
  XcdBarrier b; b.bar = bar; b.x = xb_xcc_id(); b.st = st;
  if (threadIdx.x == 0) (void)xb_add(&bar[XB_XCNT(b.x)], 1u);
  return b;
}
__device__ __forceinline__ void xcd_barrier_complete(unsigned* bar, unsigned x, unsigned& nloc, unsigned& nx) {
  const unsigned G = gridDim.x * gridDim.y * gridDim.z;
  unsigned sum, cnt, mine, sp = 0u;
  for (;;) {
    sum = 0u; cnt = 0u; mine = 0u;
#pragma unroll
    for (unsigned j = 0; j < 16; ++j) { const unsigned c = xb_ld(&bar[XB_XCNT(j)]); sum += c; cnt += (c > 0u) ? 1u : 0u; mine = (j == x) ? c : mine; }
    if (sum == G) break;
    __builtin_amdgcn_s_sleep(1);
    if ((++sp & 255u) == 0u) { if (xb_ld(&bar[XB_TMO])) break; if (sp > XB_SPIN_CAP) { atomicAdd(&bar[XB_TMO], 1u); break; } }
  }
  nloc = mine > 0u ? mine : 1u; nx = cnt > 0u ? cnt : 1u;
}
__device__ __forceinline__ void xcd_barrier(const XcdBarrier& b) {
  asm volatile("s_waitcnt vmcnt(0)" ::: "memory");
  __syncthreads();
  if (threadIdx.x == 0) {
    unsigned* bar = b.bar;
    __builtin_amdgcn_s_waitcnt(0);
    unsigned nloc = b.st[0], nx = b.st[1];
    if (nloc == 0u) { xcd_barrier_complete(bar, b.x, nloc, nx); b.st[0] = nloc; b.st[1] = nx; }
    const unsigned old = xb_add(&bar[XB_XSUB(b.x)], 1u);
    const unsigned gen = old / nloc;
    if (old + 1u == (gen + 1u) * nloc) {
      __builtin_amdgcn_fence(__ATOMIC_RELEASE, "agent");
      asm volatile("s_waitcnt vmcnt(0)" ::: "memory");
      const unsigned og = xb_add(&bar[XB_TOP], 1u);
      const unsigned tg = og / nx;
      if (og + 1u == (tg + 1u) * nx) xb_add(&bar[XB_TOPGEN], 1u);
      else XB_SPIN(xb_ld(&bar[XB_TOPGEN]) == tg, bar);
      __builtin_amdgcn_fence(__ATOMIC_ACQUIRE, "agent");
      xb_add(&bar[XB_XGEN(b.x)], 1u);
      asm volatile("s_waitcnt vmcnt(0)" ::: "memory");
    } else {
      XB_SPIN(xb_ld(&bar[XB_XGEN(b.x)]) == gen, bar);
      __builtin_amdgcn_fence(__ATOMIC_ACQUIRE, "agent");
      asm volatile("s_waitcnt vmcnt(0)" ::: "memory");
    }
  }
  __syncthreads();
}

__global__ void __launch_bounds__(512, 2) mega(Params p) {
  extern __shared__ __attribute__((aligned(16))) unsigned char lds_raw[];
  LAS unsigned char* lds = (LAS unsigned char*)lds_raw;
  cg::grid_group grid = cg::this_grid();
  unsigned char* ws = p.ws;
  bf16_t* const rR = (bf16_t*)(ws + WS_R); bf16_t* const rK = (bf16_t*)(ws + WS_K); bf16_t* const rCB = (bf16_t*)(ws + WS_CB);
  bf16_t* const rU = (bf16_t*)(ws + WS_U); bf16_t* const rV = (bf16_t*)(ws + WS_V); bf16_t* const rLOR = (bf16_t*)(ws + WS_LOR);
  bf16_t* const D0 = (bf16_t*)p.out; bf16_t* const D1 = (bf16_t*)((unsigned char*)p.out + RG);
  float* const MODP = (float*)(ws + WS_MODP); float* const MOD = (float*)(ws + WS_MOD);
  const float* xp = p.in[0]; const float* xs = p.in[1];
  pg8::StaticOrder S;
  volatile LAS unsigned* xst = (volatile LAS unsigned*)(lds + XST_OFF);
  if (threadIdx.x < 4) xst[threadIdx.x] = 0u;
  __syncthreads();
  const XcdBarrier xb = xcd_barrier_post((unsigned*)(ws + WS_BAR), xst);

  for (int rep = 0; rep < REP_P0; ++rep) {
    const int tid = opaque_tid();
    LAS float* tile = (LAS float*)lds;
    transpose_job<true>(tile, p.in[10], 8576, (bf16_t*)(ws + WS_WIN), 8704, 1024);
    if (gridDim.x != 256) {
    transpose_job<false>(tile, p.in[22], 1024, (bf16_t*)(ws + WS_WPA), 1024, 1024);
    transpose_job<false>(tile, p.in[23], 1024, (bf16_t*)(ws + WS_WPB), 1024, 1024);
    transpose_job<false>(tile, p.in[24], 1024, (bf16_t*)(ws + WS_WO), 1024, 1024);
    transpose_job<false>(tile, p.in[15], 1024, (bf16_t*)(ws + WS_G2T), 1024, 128); }
    for (int d = 0; d < 2; ++d) {
      transpose_job<false>(tile, p.in[12] + (size_t)d * 64 * 1024, 1024, (bf16_t*)(ws + WS_W2T) + (size_t)d * 1024 * 64, 1024, 64);
      transpose_job<false>(tile, p.in[14] + (size_t)d * 64 * 1024, 1024, (bf16_t*)(ws + WS_A2T) + (size_t)d * 1024 * 64, 1024, 64);
    }
    LAS float* sl = (LAS float*)lds;
    for (int ib = blockIdx.x; ib < 32 * 12; ib += gridDim.x) {
      const int kc = ib / 12, j = (ib % 12) * 512 + tid;
      __syncthreads();
      if (tid < 160) { const int i = tid >> 5, k = kc * 32 + (tid & 31); const float c = (i == 0) ? p.in[5][k] : p.in[4][(i - 1) * 1024 + k]; sl[tid] = c / (1.0f + __expf(-c)); }
      __syncthreads();
      float s[5] = {0.f, 0.f, 0.f, 0.f, 0.f};
      const float* wp = p.in[8] + (size_t)(kc * 32) * 6144 + j;
#pragma unroll 8
      for (int k = 0; k < 32; ++k) { const float w = wp[(size_t)k * 6144];
#pragma unroll
        for (int i = 0; i < 5; ++i) s[i] += sl[i * 32 + k] * w; }
#pragma unroll
      for (int i = 0; i < 5; ++i) MODP[((size_t)kc * 5 + i) * 6144 + j] = s[i];
    }
  }
  if (p.ws == nullptr) grid.sync();
  xcd_barrier(xb);
  for (int idx = blockIdx.x * 512 + opaque_tid(); idx < 5 * 6144; idx += gridDim.x * 512) {
    const int j = idx % 6144; float s = p.in[9][j];
    for (int kc = 0; kc < 32; ++kc) s += MODP[(size_t)kc * 5 * 6144 + idx];
    MOD[idx] = s;
  }
  xcd_barrier(xb);
  norm_rows<0>(xp, xs, p.in[6], MOD, 0, 1024, D0, nullptr);
  xcd_barrier(xb);
  { pg8::Gemm g{D0, (const bf16_t*)(ws + WS_WIN), NT, 6656, 1024, 1024}; S.init(NT, 6656, gridDim.x, blockIdx.x);
    EpiIn E{rR, rK, rV, rCB, rU, rLOR}; pg8::gemm_phase(lds, g, S, E); }
  xcd_barrier(xb);
  {
    const bool stream = (gridDim.x == 256);
    for (int u = blockIdx.x; u < (stream ? 256 : 256 + 1024); u += gridDim.x) {
      int h, dir, half, tb0 = 0, n0 = 0, tb1 = 0, tbs = 0, ns1 = 0; const float* s0 = nullptr; float* so1 = nullptr; size_t sos = 0;
      if (u < 256) { const int b = u >> 6; h = (u >> 2) & 15; dir = (u >> 1) & 1; half = u & 1;
        tb0 = NCTX + b * 4096; n0 = 64; s0 = p.in[2 + dir] + (size_t)(b * 16 + h) * 4096;
        if (stream) { tb1 = b * 256; tbs = 4 * 256; ns1 = 4; sos = (size_t)4 * 16 * 4096;
          so1 = p.out + (size_t)NT * DM + (size_t)dir * (16 * 16 * 4096) + (size_t)(b * 16 + h) * 4096; }
      } else { const int cu = u - 256; const int b = cu >> 6; h = (cu >> 2) & 15; dir = (cu >> 1) & 1; half = cu & 1;
        tb1 = b * 256; ns1 = 1; so1 = p.out + (size_t)NT * DM + (size_t)dir * (16 * 16 * 4096) + (size_t)(b * 16 + h) * 4096; }
      if (dir) scan_unit<1>(p, lds, h, half, tb0, n0, s0, tb1, tbs, 4, ns1, so1, sos, D1, stream);
      else scan_unit<0>(p, lds, h, half, tb0, n0, s0, tb1, tbs, 4, ns1, so1, sos, D0, stream);
    }
  }
  xcd_barrier(xb);
  {
    const int tid = opaque_tid(), lane = tid & 63, wid = tid >> 6;
    const bf16_t* G2T = (const bf16_t*)(ws + WS_G2T); const float* C3 = (const float*)(ws + WS_C3);
    const int gw = blockIdx.x * 8 + wid, nw = gridDim.x * 8; const int tk = lane & 15, q = lane >> 4;
    const int tpw = (NT / 16 + gridDim.x - 1) / gridDim.x;
    for (int rep = 0; rep < REP_P7; ++rep)
    for (int e = 0; e < 2; ++e) {
      const int h = wid * 2 + e;
      bf16x8 gfr[4][4]; f32x4 lw[4], lb[4];
#pragma unroll
      for (int nt = 0; nt < 4; ++nt) { lw[nt] = *(const f32x4*)(p.in[19] + h * 64 + q * 16 + nt * 4); lb[nt] = *(const f32x4*)(p.in[20] + h * 64 + q * 16 + nt * 4);
#pragma unroll
        for (int ks = 0; ks < 4; ++ks) gfr[nt][ks] = *(const bf16x8*)(G2T + (size_t)(h * 64 + (tk >> 2) * 16 + nt * 4 + (tk & 3)) * 128 + ks * 32 + q * 8); }
      for (int k = 0; k < tpw; ++k) {
        const int tt = blockIdx.x * tpw + k; if (tt >= NT / 16) break;
        const int tok = tt * 16 + tk;
        bf16x8 sfr[4];
#pragma unroll
        for (int ks = 0; ks < 4; ++ks) sfr[ks] = *(const bf16x8*)(rLOR + (size_t)tok * 384 + 256 + ks * 32 + q * 8);
        const float c3s = C3[(size_t)tok * 16 + h] + C3[((size_t)NT + tok) * 16 + h];
        const size_t off = (size_t)tok * DM + h * 64 + q * 16;
        const u32x4 yfa = *(const u32x4*)(D0 + off), yfb = *(const u32x4*)(D0 + off + 8), yba = *(const u32x4*)(D1 + off), ybb = *(const u32x4*)(D1 + off + 8);
        const u32x4 va = *(const u32x4*)(rV + off), vb = *(const u32x4*)(rV + off + 8);
        f32x4 go[4]; float wkv[4][4], vv[4][4]; float sm = 0.f;
#pragma unroll
        for (int nt = 0; nt < 4; ++nt) {
          const unsigned yf0 = (nt < 2) ? yfa[2 * nt] : yfb[2 * nt - 4], yf1 = (nt < 2) ? yfa[2 * nt + 1] : yfb[2 * nt - 3];
          const unsigned yb0 = (nt < 2) ? yba[2 * nt] : ybb[2 * nt - 4], yb1 = (nt < 2) ? yba[2 * nt + 1] : ybb[2 * nt - 3];
          const unsigned v0 = (nt < 2) ? va[2 * nt] : vb[2 * nt - 4], v1 = (nt < 2) ? va[2 * nt + 1] : vb[2 * nt - 3];
          f32x4 z = {0.f, 0.f, 0.f, 0.f};
#pragma unroll
          for (int ks = 0; ks < 4; ++ks) z = __builtin_amdgcn_mfma_f32_16x16x32_bf16(gfr[nt][ks], sfr[ks], z, 0, 0, 0);
          go[nt] = z;
          wkv[nt][0] = lo_bf(yf0) + lo_bf(yb0); wkv[nt][1] = hi_bf(yf0) + hi_bf(yb0); wkv[nt][2] = lo_bf(yf1) + lo_bf(yb1); wkv[nt][3] = hi_bf(yf1) + hi_bf(yb1);
          vv[nt][0] = lo_bf(v0); vv[nt][1] = hi_bf(v0); vv[nt][2] = lo_bf(v1); vv[nt][3] = hi_bf(v1);
          sm += wkv[nt][0] + wkv[nt][1] + wkv[nt][2] + wkv[nt][3];
        }
        sm += __shfl_xor(sm, 16); sm += __shfl_xor(sm, 32);
        const float mu = sm * (1.0f / 64.0f); float s2 = 0.f;
#pragma unroll
        for (int nt = 0; nt < 4; ++nt)
#pragma unroll
          for (int j = 0; j < 4; ++j) { const float d = wkv[nt][j] - mu; s2 += d * d; }
        s2 += __shfl_xor(s2, 16); s2 += __shfl_xor(s2, 32);
        const float rs = rsqrtf(s2 * (1.0f / 64.0f) + 64e-5f);
        u32x4 oa, ob2;
#pragma unroll
        for (int nt = 0; nt < 4; ++nt) {
          float o[4];
#pragma unroll
          for (int j = 0; j < 4; ++j) o[j] = ((wkv[nt][j] - mu) * rs * lw[nt][j] + lb[nt][j] + c3s * vv[nt][j]) * go[nt][j];
          const unsigned p0 = cvt_pk_bf16(o[0], o[1]), p1 = cvt_pk_bf16(o[2], o[3]);
          if (nt < 2) { oa[2 * nt] = p0; oa[2 * nt + 1] = p1; } else { ob2[2 * nt - 4] = p0; ob2[2 * nt - 3] = p1; } }
        *(u32x4*)(rR + off) = oa; *(u32x4*)(rR + off + 8) = ob2;
      }
    }
    norm_rows<0>(xp, xs, p.in[6], MOD, 0, 1024, rK, nullptr);
    const float* cw = p.in[21];
    const int rpw = (NT + gridDim.x - 1) / gridDim.x;
    if (gridDim.x != 256) { const int c0 = (tid & 127) * 8;
      float w0[8], w1[8], w2[8];
#pragma unroll
      for (int i = 0; i < 8; ++i) { w0[i] = cw[c0 + i]; w1[i] = cw[1024 + c0 + i]; w2[i] = cw[2048 + c0 + i]; }
      for (int li = tid; li < rpw * 128; li += 512) {
        const int tok = blockIdx.x * rpw + (li >> 7); if (tok >= NT) break;
        const int Wm = (tok < NCTX) ? 255 : 63; const int pos = tok & Wm;
        const size_t off = (size_t)tok * DM + c0;
        const u32x4 uc = *(const u32x4*)(rU + off), cbv = *(const u32x4*)(rCB + off);
        u32x4 up = {0u, 0u, 0u, 0u}, un = {0u, 0u, 0u, 0u};
        if (pos != 0) up = *(const u32x4*)(rU + off - DM);
        if (pos != Wm) un = *(const u32x4*)(rU + off + DM);
        float o[8];
#pragma unroll
        for (int i = 0; i < 4; ++i) {
          o[2 * i] = lo_bf(cbv[i]) * (w0[2 * i] * lo_bf(up[i]) + w1[2 * i] * lo_bf(uc[i]) + w2[2 * i] * lo_bf(un[i]));
          o[2 * i + 1] = hi_bf(cbv[i]) * (w0[2 * i + 1] * hi_bf(up[i]) + w1[2 * i + 1] * hi_bf(uc[i]) + w2[2 * i + 1] * hi_bf(un[i]));
        }
        u32x4 ob; ob[0] = cvt_pk_bf16(o[0], o[1]); ob[1] = cvt_pk_bf16(o[2], o[3]); ob[2] = cvt_pk_bf16(o[4], o[5]); ob[3] = cvt_pk_bf16(o[6], o[7]);
        *(u32x4*)(rCB + off) = ob;
      }
    }
  }
  xcd_barrier(xb);
  { pg8::Gemm g{rK, (const bf16_t*)(ws + WS_WIN) + (size_t)6656 * 1024, NT, 3072, 1024, 1024, rCB, (const bf16_t*)(ws + WS_WPB), 8}; S.init(NT, 3072, gridDim.x, blockIdx.x);
    EpiGate E{D0, D1, rU}; pg8::gemm_phase(lds, g, S, E); }
  xcd_barrier(xb);
  { pg8::Gemm g{rR, (const bf16_t*)(ws + WS_WPA), NT, 1024, 1024, 1024}; S.init(NT, 1024, gridDim.x, blockIdx.x);
    EpiYa E{D0, D1, rU}; pg8::gemm_phase(lds, g, S, E); }
  xcd_barrier(xb);
  { pg8::Gemm g{rU, (const bf16_t*)(ws + WS_WO), NT, 1024, 1024, 1024}; S.init(NT, 1024, gridDim.x, blockIdx.x);
    EpiResB<true> E{xp, xs, nullptr, D0, MOD + 2048, 0}; pg8::gemm_phase(lds, g, S, E); }
  xcd_barrier(xb);
  norm_rows<0, true>(nullptr, nullptr, p.in[7], MOD, 3072, 4096, rV, nullptr, D0);
  if (gridDim.x != 256) { LAS float* tile = (LAS float*)lds;
    transpose_job<false>(tile, p.in[25], 4096, (bf16_t*)(ws + WS_WFF1), 4096, 1024);
    transpose_job<false>(tile, p.in[26], 1024, (bf16_t*)(ws + WS_WFF2), 1024, 4096); }
  xcd_barrier(xb);
  { pg8::Gemm g{rV, (const bf16_t*)(ws + WS_WFF1), NT, 4096, 1024, 1024}; S.init(NT, 4096, gridDim.x, blockIdx.x);
    EpiFf1 E{rR}; pg8::gemm_phase(lds, g, S, E);
#if REP_P12 > 1
    __syncthreads(); pg8::gemm_phase(lds, g, S, E);
#endif
  }
  xcd_barrier(xb);
  { pg8::Gemm g{rR, (const bf16_t*)(ws + WS_WFF2), 16384, 1024, 4096, 4096}; S.init(16384, 1024, gridDim.x, blockIdx.x);
    EpiResB<false> E{nullptr, nullptr, D0, rV, MOD + 5120, 0}; pg8::gemm_phase(lds, g, S, E); }
  { pg8::Gemm g{rR + (size_t)16384 * 4096, (const bf16_t*)(ws + WS_WFF2), 4096, 1024, 2048, 4096}; S.init(4096, 1024, gridDim.x, blockIdx.x, 2);
    EpiFf2Split E{D0, rV, MOD + 5120, (bf16_t*)(ws + WS_LOR), 16384}; pg8::gemm_phase(lds, g, S, E); }
  xcd_barrier(xb);
  norm_rows<1, true>(nullptr, nullptr, p.in[27], MOD, 5120, 0, (bf16_t*)(ws + WS_LOR), p.out, rV);
}

extern "C" void kernel_launch(void* const* d_in, const int* in_sizes, int n_in,
                              void* d_out, int out_size, void* d_ws, size_t ws_size,
                              hipStream_t stream) {
  static int grid_blocks = 0;
  if (!grid_blocks) {
    int dev = 0, cus = 0, per_cu = 0;
    (void)hipGetDevice(&dev);
    (void)hipDeviceGetAttribute(&cus, hipDeviceAttributeMultiprocessorCount, dev);
    (void)hipFuncSetAttribute((const void*)mega, hipFuncAttributeMaxDynamicSharedMemorySize, LDS_BYTES);
    (void)hipOccupancyMaxActiveBlocksPerMultiprocessor(&per_cu, (const void*)mega, 512, LDS_BYTES);
    if (per_cu < 1) { fprintf(stderr, "occupancy query reports %d blocks per CU\n", per_cu); per_cu = 1; }
    grid_blocks = cus;
    if (ws_size < WS_END + (size_t)8 * 1024 * 1024) fprintf(stderr, "workspace too small: %zu < %zu\n", ws_size, (size_t)WS_END);
  }
  Params p{};
  for (int i = 0; i < 28 && i < n_in; ++i) p.in[i] = (const float*)d_in[i];
  p.out = (float*)d_out;
  p.ws = (unsigned char*)d_ws;
  (void)hipMemsetAsync((unsigned char*)d_ws + WS_BAR, 0, (size_t)3456 * 4, stream);
  void* args[] = {&p};
  hipError_t e = hipLaunchCooperativeKernel((void*)mega, dim3(grid_blocks), dim3(512), args, LDS_BYTES, stream);
  if (e != hipSuccess) fprintf(stderr, "cooperative launch failed: %s (grid %d)\n", hipGetErrorString(e), grid_blocks);
}
```

```cpp
#include <hip/hip_runtime.h>
#include <hip/hip_cooperative_groups.h>
#include <cstdio>
namespace cg = cooperative_groups;

#define LAS __attribute__((address_space(3)))
typedef unsigned short bf16_t;
typedef short bf16x8 __attribute__((ext_vector_type(8)));
typedef float f32x4 __attribute__((ext_vector_type(4)));
typedef unsigned u32x4 __attribute__((ext_vector_type(4)));
typedef unsigned u32x2 __attribute__((ext_vector_type(2)));

constexpr int NT = 20480;
constexpr int NCTX = 4096;
constexpr int DM = 1024;
constexpr size_t RG = (size_t)NT * DM * 2;
constexpr size_t WS_R = 0, WS_K = RG, WS_CB = 2 * RG, WS_U = 3 * RG, WS_V = 4 * RG;
constexpr size_t WS_LOR = 5 * RG;
constexpr size_t WS_WIN = WS_LOR + (size_t)NT * 384 * 2;
constexpr size_t WS_WPA = WS_WIN + (size_t)8704 * 1024 * 2;
constexpr size_t WS_WPB = WS_WPA + (size_t)1024 * 1024 * 2;
constexpr size_t WS_WO = WS_WPB + (size_t)1024 * 1024 * 2;
constexpr size_t WS_W2T = WS_WO + (size_t)1024 * 1024 * 2;
constexpr size_t WS_A2T = WS_W2T + (size_t)2 * 1024 * 64 * 2;
constexpr size_t WS_G2T = WS_A2T + (size_t)2 * 1024 * 64 * 2;
constexpr size_t WS_MODP = WS_G2T + (size_t)1024 * 128 * 2;
constexpr size_t WS_MOD = WS_MODP + (size_t)32 * 5 * 6144 * 4;
constexpr size_t WS_C3 = WS_MOD + (size_t)5 * 6144 * 4;
constexpr size_t WS_BAR = WS_C3 + (size_t)2 * NT * 16 * 4;
constexpr size_t WS_END = WS_BAR + (size_t)3456 * 4;
constexpr size_t WS_WFF1 = WS_WIN, WS_WFF2 = WS_END;
constexpr int XST_OFF = 151040;
constexpr int SC_TT = XST_OFF + 16;
constexpr int LDS_BYTES = SC_TT + 2 * 4224;
#ifndef REP_SCAN
#define REP_SCAN 1
#endif
#ifndef REP_P2
#define REP_P2 1
#endif
#ifndef REP_P12
#define REP_P12 1
#endif
#ifndef REP_P7
#define REP_P7 1
#endif
#ifndef REP_P0
#define REP_P0 1
#endif


struct Params {
  const float* in[28];
  float* out;
  unsigned char* ws;
};

__device__ __forceinline__ float bf2f(unsigned b) { return __uint_as_float(b << 16); }
typedef __bf16 bf16v2_t __attribute__((ext_vector_type(2)));
typedef float f32v2_t __attribute__((ext_vector_type(2)));
__device__ __forceinline__ unsigned cvt_pk_bf16(float lo, float hi) { const f32v2_t f = {lo, hi}; const bf16v2_t r = __builtin_convertvector(f, bf16v2_t); return __builtin_bit_cast(unsigned, r); }
__device__ __forceinline__ float lo_bf(unsigned u) { return __uint_as_float(u << 16); }
__device__ __forceinline__ float hi_bf(unsigned u) { return __uint_as_float(u & 0xffff0000u); }
__device__ __forceinline__ float sigmoidf_(float x) { return __builtin_amdgcn_rcpf(1.0f + __expf(-x)); }
template <int CTRL> __device__ __forceinline__ float dppf(float x) {
  return __int_as_float(__builtin_amdgcn_update_dpp(0, __float_as_int(x), CTRL, 0xF, 0xF, true));
}
template <int CTRL> __device__ __forceinline__ float dppo(float oldv, float x) {
  return __int_as_float(__builtin_amdgcn_update_dpp(__float_as_int(oldv), __float_as_int(x), CTRL, 0xF, 0xF, false));
}
__device__ __forceinline__ float sum8(float x) { x += dppf<0xB1>(x); x += dppf<0x4E>(x); x += dppf<0x141>(x); return x; }
__device__ __forceinline__ float sum16(float x) { x = sum8(x); x += dppf<0x140>(x); return x; }
__device__ __forceinline__ float wave_sum(float x) {
  x = sum16(x); x += __shfl_xor(x, 16); x += __shfl_xor(x, 32); return x;
}
__device__ __forceinline__ int opaque_tid() { int t = threadIdx.x; asm volatile("" : "+v"(t)); return t; }
__device__ __forceinline__ __amdgpu_buffer_rsrc_t wt_rsrc(const void* base) { return __builtin_amdgcn_make_buffer_rsrc(const_cast<void*>(base), 0, 0x7fffffff, 0x00020000); }
__device__ __forceinline__ void st16_wt(const __amdgpu_buffer_rsrc_t& rs, const void* base, const void* p, u32x4 v) {
  __builtin_amdgcn_raw_buffer_store_b128(v, rs, (unsigned)((const char*)p - (const char*)base), 0, 16); }
__device__ __forceinline__ void st8_wt(const __amdgpu_buffer_rsrc_t& rs, const void* base, const void* p, u32x2 v) {
  __builtin_amdgcn_raw_buffer_store_b64(v, rs, (unsigned)((const char*)p - (const char*)base), 0, 16); }
__device__ __forceinline__ int mod_index(int row) { return row < NCTX ? 0 : 1 + ((row - NCTX) >> 12); }

namespace pg8 {
constexpr int BM = 256, BK = 64, HALF = 128, HTB = HALF * BK * 2, STAGE_BYTES = 8 * HTB, NXCD = 8, WGM = 8;
__device__ __forceinline__ int lds_byte(int r, int c) { const int st = (r >> 4) * 2 + (c >> 5), rr = r & 15, cc = c & 31, ob = rr * 64 + cc * 2; return st * 1024 + (ob ^ (((ob >> 9) & 1) << 5)); }
__device__ __forceinline__ void stage_rc(int b, int& R, int& C) { const int st = b / 1024, sb = b % 1024, swz = sb ^ (((sb >> 9) & 1) << 5); R = (st >> 1) * 16 + swz / 64; C = (st & 1) * 32 + (swz % 64) / 2; }
__device__ __forceinline__ int perm32(int rho) { const int n = rho >> 4, i = rho & 15; return 8 * (i >> 2) + 4 * n + (i & 3); }
struct Unit { int pm, pn, ks; };
struct Gemm { const bf16_t* A; const bf16_t* Bt; int M, N, K, ld; const bf16_t* A2 = nullptr; const bf16_t* Bt2 = nullptr; int nsplit = 1 << 30; };
struct StaticOrder {
  int nM, nN, nwg, G, c, nNr;
  __device__ void init(int M, int N, int G_, int c_, int ksplit = 1) { nM = M / BM; nNr = N / BM; nN = nNr * ksplit; nwg = nM * nN; G = G_; c = c_; }
  __device__ bool next(int i, Unit& u) const {
    const long L = (long)i * G + c; if (L >= nwg) return false;
    int wgid = (int)L; { const int q = nwg / NXCD, r = nwg % NXCD, xcd = wgid % NXCD, off = wgid / NXCD; wgid = (xcd < r ? xcd * (q + 1) : r * (q + 1) + (xcd - r) * q) + off; }
    const int nig = WGM * nN, gid = wgid / nig, fm = gid * WGM, gsz = (nM - fm) < WGM ? (nM - fm) : WGM;
    u.pm = fm + ((wgid % nig) % gsz); const int pv = (wgid % nig) / gsz; u.pn = pv % nNr; u.ks = pv / nNr; return true;
  }
};
template <class Epi>
__device__ __forceinline__ void gemm_phase(LAS unsigned char* lds, const Gemm g, const StaticOrder& S, const Epi& E) {
  const int tid = opaque_tid(), wid = __builtin_amdgcn_readfirstlane(tid >> 6), lane = tid & 63, wr = wid >> 2, wc = wid & 3, fr = lane & 15, fq = lane >> 4;
  const int K = g.K, nt = K / BK, LD = g.ld;
  unsigned voffA[2], voffB[2];
#pragma unroll
  for (int i = 0; i < 2; ++i) { int R, C; stage_rc(tid * 16 + i * 8192, R, C); const int Rb = Epi::PERM ? ((R & ~31) + perm32(R & 31)) : R;
    voffA[i] = (unsigned)(R * LD + C) * 2u; voffB[i] = (unsigned)(Rb * LD + C) * 2u; }
  const size_t kstep = (size_t)(BK * 2);
  const size_t hstep = (size_t)HALF * LD * 2;
  const size_t ksb = (size_t)K * 2;
  const size_t tstep = 2 * hstep;
  const unsigned ldsw = (unsigned)wid * 1024u;
  const int aoff = lds_byte(wr * 64 + fr, fq * 8), boff = lds_byte(wc * 32 + fr, fq * 8);
#define PG8_SA(b, h) (((b) * 2 + (h)) * HTB)
#define PG8_SB(b, h) ((4 + (b) * 2 + (h)) * HTB)
#define PG8_STAGE(bufoff, gbase, voff) do { _Pragma("unroll") for (int _i = 0; _i < 2; ++_i) \
    __builtin_amdgcn_global_load_lds((const unsigned*)((const char*)(gbase) + (voff)[_i]), (LAS unsigned*)(lds + (bufoff) + ldsw + _i * 8192), 16, 0, 0); } while (0)
#define PG8_LDA(dst, b, h) do { _Pragma("unroll") for (int m = 0; m < 4; ++m) _Pragma("unroll") for (int k = 0; k < 2; ++k) dst[m][k] = *(const LAS bf16x8*)(lds + PG8_SA(b, h) + aoff + m * 2048 + k * 1024); } while (0)
#define PG8_LDB(dst, b, h) do { _Pragma("unroll") for (int n = 0; n < 2; ++n) _Pragma("unroll") for (int k = 0; k < 2; ++k) dst[n][k] = *(const LAS bf16x8*)(lds + PG8_SB(b, h) + boff + n * 2048 + k * 1024); } while (0)
#define PG8_MMA(ai, bj, At, Bt) do { __builtin_amdgcn_s_setprio(1); _Pragma("unroll") for (int m = 0; m < 4; ++m) _Pragma("unroll") for (int n = 0; n < 2; ++n) _Pragma("unroll") for (int k = 0; k < 2; ++k) \
    acc[ai][bj][m][n] = __builtin_amdgcn_mfma_f32_16x16x32_bf16(Bt[n][k], At[m][k], acc[ai][bj][m][n], 0, 0, 0); __builtin_amdgcn_s_setprio(0); } while (0)
#define PG8_WAIT_V(n) asm volatile("s_waitcnt vmcnt(" #n ")" ::: "memory")
#define PG8_WAIT_L(n) asm volatile("s_waitcnt lgkmcnt(" #n ")" ::: "memory")
#define PG8_BAR __builtin_amdgcn_s_barrier()
#define PG8_SCHED __builtin_amdgcn_sched_barrier(0)
  Unit cur, nxt; int ui = 0;
  if (!S.next(0, cur)) return;
  f32x4 acc[2][2][4][2];
#pragma unroll
  for (int a = 0; a < 2; ++a)
#pragma unroll
    for (int b = 0; b < 2; ++b)
#pragma unroll
      for (int m = 0; m < 4; ++m)
#pragma unroll
        for (int n = 0; n < 2; ++n) acc[a][b][m][n] = (f32x4){0.f, 0.f, 0.f, 0.f};
  bf16x8 At[4][2], B0[2][2], B1[2][2];
  const long dA2 = g.A2 ? (long)((const char*)g.A2 - (const char*)g.A) : 0L;
  const long dB2 = g.Bt2 ? (long)((const char*)g.Bt2 - (const char*)g.Bt) - (long)g.nsplit * (long)tstep : 0L;
#define PG8_UA(u_) ((const char*)g.A + (size_t)(u_).pm * tstep + (size_t)(u_).ks * ksb + ((u_).pn >= g.nsplit ? dA2 : 0L))
#define PG8_UB(u_) ((const char*)g.Bt + (size_t)(u_).pn * tstep + (size_t)(u_).ks * ksb + ((u_).pn >= g.nsplit ? dB2 : 0L))
  const char* cA = PG8_UA(cur); const char* cB = PG8_UB(cur);
  PG8_STAGE(PG8_SB(0, 0), cB, voffB); PG8_STAGE(PG8_SA(0, 0), cA, voffA); PG8_STAGE(PG8_SB(0, 1), cB + hstep, voffB); PG8_STAGE(PG8_SA(0, 1), cA + hstep, voffA);
  if (wr == 1) PG8_BAR;
  PG8_WAIT_V(4); PG8_BAR;
  PG8_STAGE(PG8_SB(1, 0), cB + kstep, voffB); PG8_STAGE(PG8_SA(1, 0), cA + kstep, voffA); PG8_STAGE(PG8_SB(1, 1), cB + hstep + kstep, voffB);
  PG8_WAIT_V(6); PG8_BAR;
  for (;;) {
    const bool has_next = S.next(ui + 1, nxt);
    const char* nA = has_next ? PG8_UA(nxt) : cA; const char* nB = has_next ? PG8_UB(nxt) : cB;
    for (int t = 0; t < nt; t += 2) {
      const bool last = (t == nt - 2);
      const char* a1 = cA + (size_t)(t + 1) * kstep;
      const char* a2 = last ? nA : cA + (size_t)(t + 2) * kstep; const char* b2 = last ? nB : cB + (size_t)(t + 2) * kstep;
      const char* a3 = a2 + kstep; const char* b3 = b2 + kstep;
      PG8_LDB(B0, 0, 0); PG8_SCHED; PG8_LDA(At, 0, 0); PG8_STAGE(PG8_SA(1, 1), a1 + hstep, voffA);
      PG8_WAIT_L(8); PG8_BAR; PG8_WAIT_L(0); PG8_MMA(0, 0, At, B0); PG8_BAR; PG8_SCHED;
      PG8_LDB(B1, 0, 1); PG8_STAGE(PG8_SB(0, 0), b2, voffB);
      PG8_BAR; PG8_WAIT_L(0); PG8_MMA(0, 1, At, B1); PG8_BAR;
      PG8_LDA(At, 0, 1); PG8_STAGE(PG8_SA(0, 0), a2, voffA);
      PG8_BAR; PG8_WAIT_L(0); PG8_MMA(1, 0, At, B0); PG8_BAR; PG8_SCHED;
      PG8_STAGE(PG8_SB(0, 1), b2 + hstep, voffB);
      PG8_WAIT_V(6); PG8_BAR; PG8_MMA(1, 1, At, B1); PG8_BAR;
      PG8_LDB(B0, 1, 0); PG8_SCHED; PG8_LDA(At, 1, 0); PG8_STAGE(PG8_SA(0, 1), a2 + hstep, voffA);
      PG8_WAIT_L(8); PG8_BAR; PG8_WAIT_L(0); PG8_MMA(0, 0, At, B0); PG8_BAR; PG8_SCHED;
      PG8_LDB(B1, 1, 1); PG8_STAGE(PG8_SB(1, 0), b3, voffB);
      PG8_BAR; PG8_WAIT_L(0); PG8_MMA(0, 1, At, B1); PG8_BAR;
      PG8_LDA(At, 1, 1); PG8_STAGE(PG8_SA(1, 0), a3, voffA);
      PG8_BAR; PG8_WAIT_L(0); PG8_MMA(1, 0, At, B0); PG8_BAR; PG8_SCHED;
      PG8_STAGE(PG8_SB(1, 1), b3 + hstep, voffB);
      PG8_WAIT_V(6); PG8_BAR; PG8_MMA(1, 1, At, B1); PG8_BAR;
    }
    E(acc, cur, wr, wc, fr, fq);
    if (!has_next) break;
#pragma unroll
    for (int a = 0; a < 2; ++a)
#pragma unroll
      for (int b = 0; b < 2; ++b)
#pragma unroll
        for (int m = 0; m < 4; ++m)
#pragma unroll
          for (int n = 0; n < 2; ++n) acc[a][b][m][n] = (f32x4){0.f, 0.f, 0.f, 0.f};
    cur = nxt; cA = nA; cB = nB; ++ui;
  }
  PG8_WAIT_V(0);
  if (wr == 0) PG8_BAR;
  PG8_BAR;
#undef PG8_UA
#undef PG8_UB
#undef PG8_SA
#undef PG8_SB
#undef PG8_STAGE
#undef PG8_LDA
#undef PG8_LDB
#undef PG8_MMA
#undef PG8_WAIT_V
#undef PG8_WAIT_L
#undef PG8_BAR
#undef PG8_SCHED
}
}
using pg8::Unit;
typedef f32x4 AccT[2][2][4][2];

struct EpiIn {
  static constexpr bool PERM = true;
  bf16_t *R, *K, *V, *CB, *U, *LOR;
  __device__ __forceinline__ void operator()(const AccT& acc, const Unit& u, int wr, int wc, int fr, int fq) const {
    const int row0 = u.pm * 256 + wr * 64 + fr;
    const __amdgpu_buffer_rsrc_t rs = wt_rsrc(R);
    if (u.pn < 16) {
      bf16_t* base = (u.pn < 4) ? R : (u.pn < 8) ? K : (u.pn < 12) ? V : CB;
      const int col0 = (u.pn & 3) * 256 + wc * 32 + 8 * fq;
#pragma unroll
      for (int ai = 0; ai < 2; ++ai)
#pragma unroll
        for (int m = 0; m < 4; ++m) { bf16_t* rowp = base + (size_t)(row0 + ai * 128 + m * 16) * DM + col0;
#pragma unroll
          for (int bj = 0; bj < 2; ++bj) { const f32x4 v0 = acc[ai][bj][m][0], v1 = acc[ai][bj][m][1];
            u32x4 o; o[0] = cvt_pk_bf16(v0[0], v0[1]); o[1] = cvt_pk_bf16(v0[2], v0[3]); o[2] = cvt_pk_bf16(v1[0], v1[1]); o[3] = cvt_pk_bf16(v1[2], v1[3]);
            st16_wt(rs, R, rowp + bj * 128, o); } }
    } else if (u.pn < 24) {
      const int ch0 = (u.pn - 16) * 128 + wc * 32 + 8 * fq;
#pragma unroll
      for (int ai = 0; ai < 2; ++ai)
#pragma unroll
        for (int m = 0; m < 4; ++m) { bf16_t* rowp = U + (size_t)(row0 + ai * 128 + m * 16) * DM + ch0;
          const f32x4 p0 = acc[ai][0][m][0] * acc[ai][0][m][1], p1 = acc[ai][1][m][0] * acc[ai][1][m][1];
          u32x4 o; o[0] = cvt_pk_bf16(p0[0], p0[1]); o[1] = cvt_pk_bf16(p0[2], p0[3]); o[2] = cvt_pk_bf16(p1[0], p1[1]); o[3] = cvt_pk_bf16(p1[2], p1[3]);
          st16_wt(rs, R, rowp, o); }
    } else {
      const int colw = wc * 32 + 8 * fq;
#pragma unroll
      for (int ai = 0; ai < 2; ++ai)
#pragma unroll
        for (int m = 0; m < 4; ++m) { bf16_t* rowp = LOR + (size_t)(row0 + ai * 128 + m * 16) * 384;
#pragma unroll
          for (int bj = 0; bj < 2; ++bj) {
            f32x4 v0 = acc[ai][bj][m][0], v1 = acc[ai][bj][m][1];
            if (u.pn == 24) {
              if (bj == 0) {
#pragma unroll
                for (int j = 0; j < 4; ++j) { v0[j] = 1.0f - 2.0f * __builtin_amdgcn_rcpf(1.0f + __expf(2.0f * v0[j])); v1[j] = 1.0f - 2.0f * __builtin_amdgcn_rcpf(1.0f + __expf(2.0f * v1[j])); }
              }
              u32x4 o; o[0] = cvt_pk_bf16(v0[0], v0[1]); o[1] = cvt_pk_bf16(v0[2], v0[3]); o[2] = cvt_pk_bf16(v1[0], v1[1]); o[3] = cvt_pk_bf16(v1[2], v1[3]);
              *(u32x4*)(rowp + bj * 128 + colw) = o;
            } else if (bj == 0) {
#pragma unroll
              for (int j = 0; j < 4; ++j) { v0[j] = sigmoidf_(v0[j]); v1[j] = sigmoidf_(v1[j]); }
              u32x4 o; o[0] = cvt_pk_bf16(v0[0], v0[1]); o[1] = cvt_pk_bf16(v0[2], v0[3]); o[2] = cvt_pk_bf16(v1[0], v1[1]); o[3] = cvt_pk_bf16(v1[2], v1[3]);
              *(u32x4*)(rowp + 256 + colw) = o;
            }
          } }
    }
  }
};
struct EpiGate {
  static constexpr bool PERM = true;
  bf16_t *GA, *GB, *YR;
  __device__ __forceinline__ void operator()(const AccT& acc, const Unit& u, int wr, int wc, int fr, int fq) const {
    const int row0 = u.pm * 256 + wr * 64 + fr;
    long boff = 0L; if (u.pn >= 4) boff = (long)((char*)GB - (char*)GA); if (u.pn >= 8) boff = (long)((char*)YR - (char*)GA);
    bf16_t* base = (bf16_t*)((char*)GA + boff);
    const bool sg = u.pn < 8;
    const int col0 = (u.pn & 3) * 256 + wc * 32 + 8 * fq;
#pragma unroll
    for (int ai = 0; ai < 2; ++ai)
#pragma unroll
      for (int m = 0; m < 4; ++m) { bf16_t* rowp = base + (size_t)(row0 + ai * 128 + m * 16) * DM + col0;
#pragma unroll
        for (int bj = 0; bj < 2; ++bj) { f32x4 v0 = acc[ai][bj][m][0], v1 = acc[ai][bj][m][1];
          if (sg) {
#pragma unroll
            for (int j = 0; j < 4; ++j) { v0[j] = sigmoidf_(v0[j]); v1[j] = sigmoidf_(v1[j]); } }
          u32x4 o; o[0] = cvt_pk_bf16(v0[0], v0[1]); o[1] = cvt_pk_bf16(v0[2], v0[3]); o[2] = cvt_pk_bf16(v1[0], v1[1]); o[3] = cvt_pk_bf16(v1[2], v1[3]);
          *(u32x4*)(rowp + bj * 128) = o; } }
  }
};
struct EpiYa {
  static constexpr bool PERM = true;
  const bf16_t* GA; const bf16_t* GB; bf16_t* O;
  __device__ __forceinline__ void operator()(const AccT& acc, const Unit& u, int wr, int wc, int fr, int fq) const {
    const int row0 = u.pm * 256 + wr * 64 + fr; const int col0 = u.pn * 256 + wc * 32 + 8 * fq;
#pragma unroll
    for (int ai = 0; ai < 2; ++ai)
#pragma unroll
      for (int m = 0; m < 4; ++m) { const size_t off = (size_t)(row0 + ai * 128 + m * 16) * DM + col0;
#pragma unroll
        for (int bj = 0; bj < 2; ++bj) { const f32x4 v0 = acc[ai][bj][m][0], v1 = acc[ai][bj][m][1];
          const u32x4 ga = *(const u32x4*)(GA + off + bj * 128), gb = *(const u32x4*)(GB + off + bj * 128), yr = *(const u32x4*)(O + off + bj * 128);
          float r[8];
          r[0] = lo_bf(ga[0]) * v0[0] + lo_bf(gb[0]) * lo_bf(yr[0]); r[1] = hi_bf(ga[0]) * v0[1] + hi_bf(gb[0]) * hi_bf(yr[0]);
          r[2] = lo_bf(ga[1]) * v0[2] + lo_bf(gb[1]) * lo_bf(yr[1]); r[3] = hi_bf(ga[1]) * v0[3] + hi_bf(gb[1]) * hi_bf(yr[1]);
          r[4] = lo_bf(ga[2]) * v1[0] + lo_bf(gb[2]) * lo_bf(yr[2]); r[5] = hi_bf(ga[2]) * v1[1] + hi_bf(gb[2]) * hi_bf(yr[2]);
          r[6] = lo_bf(ga[3]) * v1[2] + lo_bf(gb[3]) * lo_bf(yr[3]); r[7] = hi_bf(ga[3]) * v1[3] + hi_bf(gb[3]) * hi_bf(yr[3]);
          u32x4 o; o[0] = cvt_pk_bf16(r[0], r[1]); o[1] = cvt_pk_bf16(r[2], r[3]); o[2] = cvt_pk_bf16(r[4], r[5]); o[3] = cvt_pk_bf16(r[6], r[7]);
          *(u32x4*)(O + off + bj * 128) = o; } }
  }
};
template <bool ADD> struct EpiY {
  static constexpr bool PERM = true;
  const bf16_t* G; bf16_t* O;
  __device__ __forceinline__ void operator()(const AccT& acc, const Unit& u, int wr, int wc, int fr, int fq) const {
    const int row0 = u.pm * 256 + wr * 64 + fr; const int col0 = u.pn * 256 + wc * 32 + 8 * fq;
#pragma unroll
    for (int ai = 0; ai < 2; ++ai)
#pragma unroll
      for (int m = 0; m < 4; ++m) { const size_t off = (size_t)(row0 + ai * 128 + m * 16) * DM + col0;
#pragma unroll
        for (int bj = 0; bj < 2; ++bj) { const f32x4 v0 = acc[ai][bj][m][0], v1 = acc[ai][bj][m][1];
          const u32x4 g = *(const u32x4*)(G + off + bj * 128);
          float r[8];
          r[0] = lo_bf(g[0]) * v0[0]; r[1] = hi_bf(g[0]) * v0[1]; r[2] = lo_bf(g[1]) * v0[2]; r[3] = hi_bf(g[1]) * v0[3];
          r[4] = lo_bf(g[2]) * v1[0]; r[5] = hi_bf(g[2]) * v1[1]; r[6] = lo_bf(g[3]) * v1[2]; r[7] = hi_bf(g[3]) * v1[3];
          if (ADD) { const u32x4 p = *(const u32x4*)(O + off + bj * 128);
            r[0] += lo_bf(p[0]); r[1] += hi_bf(p[0]); r[2] += lo_bf(p[1]); r[3] += hi_bf(p[1]);
            r[4] += lo_bf(p[2]); r[5] += hi_bf(p[2]); r[6] += lo_bf(p[3]); r[7] += hi_bf(p[3]); }
          u32x4 o; o[0] = cvt_pk_bf16(r[0], r[1]); o[1] = cvt_pk_bf16(r[2], r[3]); o[2] = cvt_pk_bf16(r[4], r[5]); o[3] = cvt_pk_bf16(r[6], r[7]);
          *(u32x4*)(O + off + bj * 128) = o; } }
  }
};
struct EpiRes {
  static constexpr bool PERM = false;
  const float* x0; const float* x1; float* OUT; const float* gate;
  __device__ __forceinline__ void operator()(const AccT& acc, const Unit& u, int wr, int wc, int fr, int fq) const {
    const int rowt = u.pm * 256; const int mi = mod_index(rowt);
    const int row0 = rowt + wr * 64 + fr, col0 = u.pn * 256 + wc * 32 + 4 * fq;
    const float* gp = gate + (size_t)mi * 6144 + col0;
    f32x4 gv[2][2];
#pragma unroll
    for (int bj = 0; bj < 2; ++bj)
#pragma unroll
      for (int n = 0; n < 2; ++n) gv[bj][n] = *(const f32x4*)(gp + bj * 128 + n * 16);
#pragma unroll
    for (int ai = 0; ai < 2; ++ai)
#pragma unroll
      for (int m = 0; m < 4; ++m) { const int row = row0 + ai * 128 + m * 16;
        const float* xr = x0 ? ((row < NCTX) ? x0 + (size_t)row * DM : x1 + (size_t)(row - NCTX) * DM) : OUT + (size_t)row * DM;
        float* orow = OUT + (size_t)row * DM;
#pragma unroll
        for (int bj = 0; bj < 2; ++bj)
#pragma unroll
          for (int n = 0; n < 2; ++n) { const int c = col0 + bj * 128 + n * 16;
            const f32x4 xv = *(const f32x4*)(xr + c);
            *(f32x4*)(orow + c) = xv + gv[bj][n] * acc[ai][bj][m][n]; } }
  }
};
template <bool FROMX> struct EpiResB {
  static constexpr bool PERM = true;
  const float* x0; const float* x1; const bf16_t* XI; bf16_t* XO; const float* gate; int row_base;
  __device__ __forceinline__ void operator()(const AccT& acc, const Unit& u, int wr, int wc, int fr, int fq) const {
    const int rowt = row_base + u.pm * 256; const int mi = mod_index(rowt);
    const int row0 = rowt + wr * 64 + fr, col0 = u.pn * 256 + wc * 32 + 8 * fq;
    const float* gp = gate + (size_t)mi * 6144 + col0;
    f32x4 gv[2][2];
#pragma unroll
    for (int bj = 0; bj < 2; ++bj)
#pragma unroll
      for (int n = 0; n < 2; ++n) gv[bj][n] = *(const f32x4*)(gp + bj * 128 + 4 * n);
#pragma unroll
    for (int ai = 0; ai < 2; ++ai)
#pragma unroll
      for (int m = 0; m < 4; ++m) { const int row = row0 + ai * 128 + m * 16;
        const float* xr = FROMX ? ((row < NCTX) ? x0 + (size_t)row * DM : x1 + (size_t)(row - NCTX) * DM) : nullptr;
#pragma unroll
        for (int bj = 0; bj < 2; ++bj) { const int c = col0 + bj * 128;
          f32x4 xa, xb;
          if (FROMX) { xa = *(const f32x4*)(xr + c); xb = *(const f32x4*)(xr + c + 4); }
          else { const u32x4 pv = *(const u32x4*)(XI + (size_t)row * DM + c); xa = (f32x4){lo_bf(pv[0]), hi_bf(pv[0]), lo_bf(pv[1]), hi_bf(pv[1])}; xb = (f32x4){lo_bf(pv[2]), hi_bf(pv[2]), lo_bf(pv[3]), hi_bf(pv[3])}; }
          const f32x4 oa = xa + gv[bj][0] * acc[ai][bj][m][0], ob = xb + gv[bj][1] * acc[ai][bj][m][1];
          u32x4 o; o[0] = cvt_pk_bf16(oa[0], oa[1]); o[1] = cvt_pk_bf16(oa[2], oa[3]); o[2] = cvt_pk_bf16(ob[0], ob[1]); o[3] = cvt_pk_bf16(ob[2], ob[3]);
          *(u32x4*)(XO + (size_t)row * DM + c) = o; } }
  }
};
struct EpiFf2Split {
  static constexpr bool PERM = true;
  const bf16_t* XI; bf16_t* XO; const float* gate; bf16_t* PART; int row_base;
  __device__ __forceinline__ void operator()(const AccT& acc, const Unit& u, int wr, int wc, int fr, int fq) const {
    const int rowl0 = u.pm * 256 + wr * 64 + fr, col0 = u.pn * 256 + wc * 32 + 8 * fq;
    if (u.ks == 0) {
      const float* gp = gate + (size_t)mod_index(row_base + u.pm * 256) * 6144 + col0;
      f32x4 gv[2][2];
#pragma unroll
      for (int bj = 0; bj < 2; ++bj)
#pragma unroll
        for (int n = 0; n < 2; ++n) gv[bj][n] = *(const f32x4*)(gp + bj * 128 + 4 * n);
#pragma unroll
      for (int ai = 0; ai < 2; ++ai)
#pragma unroll
        for (int m = 0; m < 4; ++m) { const size_t ro = (size_t)(row_base + rowl0 + ai * 128 + m * 16) * DM;
#pragma unroll
          for (int bj = 0; bj < 2; ++bj) { const int c = col0 + bj * 128; const u32x4 pv = *(const u32x4*)(XI + ro + c);
            const f32x4 xa = {lo_bf(pv[0]), hi_bf(pv[0]), lo_bf(pv[1]), hi_bf(pv[1])}, xb = {lo_bf(pv[2]), hi_bf(pv[2]), lo_bf(pv[3]), hi_bf(pv[3])};
            const f32x4 oa = xa + gv[bj][0] * acc[ai][bj][m][0], ob = xb + gv[bj][1] * acc[ai][bj][m][1];
            u32x4 o; o[0] = cvt_pk_bf16(oa[0], oa[1]); o[1] = cvt_pk_bf16(oa[2], oa[3]); o[2] = cvt_pk_bf16(ob[0], ob[1]); o[3] = cvt_pk_bf16(ob[2], ob[3]);
            *(u32x4*)(XO + ro + c) = o; } }
    } else {
#pragma unroll
      for (int ai = 0; ai < 2; ++ai)
#pragma unroll
        for (int m = 0; m < 4; ++m) { bf16_t* prow = PART + (size_t)(rowl0 + ai * 128 + m * 16) * DM;
#pragma unroll
          for (int bj = 0; bj < 2; ++bj) { const f32x4 v0 = acc[ai][bj][m][0], v1 = acc[ai][bj][m][1];
            u32x4 o; o[0] = cvt_pk_bf16(v0[0], v0[1]); o[1] = cvt_pk_bf16(v0[2], v0[3]); o[2] = cvt_pk_bf16(v1[0], v1[1]); o[3] = cvt_pk_bf16(v1[2], v1[3]);
            *(u32x4*)(prow + col0 + bj * 128) = o; } }
    }
  }
};
struct EpiFf1 {
  static constexpr bool PERM = true;
  bf16_t* H;
  __device__ __forceinline__ void operator()(const AccT& acc, const Unit& u, int wr, int wc, int fr, int fq) const {
    const int row0 = u.pm * 256 + wr * 64 + fr; const int col0 = u.pn * 256 + wc * 32 + 8 * fq;
    const __amdgpu_buffer_rsrc_t rs = wt_rsrc(H);
#pragma unroll
    for (int ai = 0; ai < 2; ++ai)
#pragma unroll
      for (int m = 0; m < 4; ++m) { bf16_t* rowp = H + (size_t)(row0 + ai * 128 + m * 16) * 4096 + col0;
#pragma unroll
        for (int bj = 0; bj < 2; ++bj) { f32x4 v0 = acc[ai][bj][m][0], v1 = acc[ai][bj][m][1];
#pragma unroll
          for (int j = 0; j < 4; ++j) { const float a = fmaxf(v0[j], 0.f), b = fmaxf(v1[j], 0.f); v0[j] = a * a; v1[j] = b * b; }
          u32x4 o; o[0] = cvt_pk_bf16(v0[0], v0[1]); o[1] = cvt_pk_bf16(v0[2], v0[3]); o[2] = cvt_pk_bf16(v1[0], v1[1]); o[3] = cvt_pk_bf16(v1[2], v1[3]);
          st16_wt(rs, H, rowp + bj * 128, o); } }
  }
};

__device__ __forceinline__ int win_col(int o) {
  if (o < 3072) return o;
  if (o < 4096) return 3456 + (o - 3072);
  if (o < 6144) { const int t = (o - 4096) >> 8, l = (o - 4096) & 255;
    const int bj = l >> 7, wc = (l >> 5) & 3, fq = (l >> 3) & 3, n = (l >> 2) & 1, j = l & 3;
    return (n ? 5504 : 4480) + t * 128 + wc * 32 + fq * 8 + bj * 4 + j; }
  if (o < 6656) { const int l = o - 6144; return l < 384 ? 3072 + l : -1; }
  return 6528 + (o - 6656);
}
template <bool WIN>
__device__ void transpose_job(LAS float* tile, const float* src, int srcN, bf16_t* dst, int O, int K) {
  const int tid = opaque_tid(), nkt = K / 64, ntiles = (O / 64) * nkt;
  for (int tI = blockIdx.x; tI < ntiles; tI += gridDim.x) {
    const int o0 = (tI / nkt) * 64, k0 = (tI % nkt) * 64;
    { const int tx = (tid & 15) * 4, ty = tid >> 4; const int o = o0 + tx; const int c = WIN ? win_col(o) : o;
#pragma unroll
      for (int i = 0; i < 2; ++i) { const int kl = ty + 32 * i; const f32x4 v = (c >= 0) ? *(const f32x4*)(src + (size_t)(k0 + kl) * srcN + c) : (f32x4){0.f, 0.f, 0.f, 0.f};
        tile[kl * 65 + tx] = v[0]; tile[kl * 65 + tx + 1] = v[1]; tile[kl * 65 + tx + 2] = v[2]; tile[kl * 65 + tx + 3] = v[3]; } }
    __syncthreads();
    { const int oy = tid >> 3, kx = (tid & 7) * 8; float v[8];
#pragma unroll
      for (int i = 0; i < 8; ++i) v[i] = tile[(kx + i) * 65 + oy];
      u32x4 o; o[0] = cvt_pk_bf16(v[0], v[1]); o[1] = cvt_pk_bf16(v[2], v[3]); o[2] = cvt_pk_bf16(v[4], v[5]); o[3] = cvt_pk_bf16(v[6], v[7]);
      *(u32x4*)(dst + (size_t)(o0 + oy) * K + k0 + kx) = o; }
    __syncthreads();
  }
}

template <int MODE, bool SRC16 = false>
__device__ void norm_rows(const float* x0, const float* x1, const float* g, const float* mod, int sh_off, int sc_off, bf16_t* dst, float* fout, const bf16_t* src16 = nullptr) {
  const int tid_ = opaque_tid(); const int lane = tid_ & 63, gw = blockIdx.x * 8 + (tid_ >> 6), nw = gridDim.x * 8;
  f32x4 gv[4];
#pragma unroll
  for (int i = 0; i < 4; ++i) gv[i] = *(const f32x4*)(g + i * 256 + lane * 4);
  const int rpw = (NT + gridDim.x - 1) / gridDim.x, rpv = (rpw + 7) / 8;
  const int rbeg = blockIdx.x * rpw + (tid_ >> 6) * rpv, rend = min(min(rbeg + rpv, (int)(blockIdx.x + 1) * rpw), NT);
  int cmi = -1; f32x4 scv[4], shv[4];
#pragma unroll
  for (int i = 0; i < 4; ++i) { scv[i] = (f32x4){0.f, 0.f, 0.f, 0.f}; shv[i] = (f32x4){0.f, 0.f, 0.f, 0.f}; }
  for (int row = rbeg; row < rend; row += 2) {
    const int rowb = (row + 1 < rend) ? (row + 1) : row;
    const float* xa = (row < NCTX) ? x0 + (size_t)row * DM : x1 + (size_t)(row - NCTX) * DM;
    const float* xb = (rowb < NCTX) ? x0 + (size_t)rowb * DM : x1 + (size_t)(rowb - NCTX) * DM;
    f32x4 va[4], vb[4]; float sa = 0.f, sb = 0.f;
    if (SRC16) {
#pragma unroll
      for (int i = 0; i < 4; ++i) { const u32x2 pa = *(const u32x2*)(src16 + (size_t)row * DM + i * 256 + lane * 4), pb = *(const u32x2*)(src16 + (size_t)rowb * DM + i * 256 + lane * 4);
        va[i] = (f32x4){lo_bf(pa[0]), hi_bf(pa[0]), lo_bf(pa[1]), hi_bf(pa[1])}; vb[i] = (f32x4){lo_bf(pb[0]), hi_bf(pb[0]), lo_bf(pb[1]), hi_bf(pb[1])}; }
    } else {
#pragma unroll
      for (int i = 0; i < 4; ++i) { va[i] = *(const f32x4*)(xa + i * 256 + lane * 4); vb[i] = *(const f32x4*)(xb + i * 256 + lane * 4); }
    }
    if (MODE == 1) {
      if (row >= 16384) { const float* gp = mod + (size_t)mod_index(row) * 6144 + sh_off; const bf16_t* pp = dst + (size_t)(row - 16384) * DM;
#pragma unroll
        for (int i = 0; i < 4; ++i) { const int cc = i * 256 + lane * 4; const u32x2 pv = *(const u32x2*)(pp + cc); const f32x4 gt = *(const f32x4*)(gp + cc);
          va[i][0] += gt[0] * lo_bf(pv[0]); va[i][1] += gt[1] * hi_bf(pv[0]); va[i][2] += gt[2] * lo_bf(pv[1]); va[i][3] += gt[3] * hi_bf(pv[1]); } }
      if (rowb >= 16384) { const float* gp = mod + (size_t)mod_index(rowb) * 6144 + sh_off; const bf16_t* pp = dst + (size_t)(rowb - 16384) * DM;
#pragma unroll
        for (int i = 0; i < 4; ++i) { const int cc = i * 256 + lane * 4; const u32x2 pv = *(const u32x2*)(pp + cc); const f32x4 gt = *(const f32x4*)(gp + cc);
          vb[i][0] += gt[0] * lo_bf(pv[0]); vb[i][1] += gt[1] * hi_bf(pv[0]); vb[i][2] += gt[2] * lo_bf(pv[1]); vb[i][3] += gt[3] * hi_bf(pv[1]); } }
    }
#pragma unroll
    for (int i = 0; i < 4; ++i) { sa += va[i][0] * va[i][0] + va[i][1] * va[i][1] + va[i][2] * va[i][2] + va[i][3] * va[i][3];
                                  sb += vb[i][0] * vb[i][0] + vb[i][1] * vb[i][1] + vb[i][2] * vb[i][2] + vb[i][3] * vb[i][3]; }
    sa = wave_sum(sa); sb = wave_sum(sb);
    const float ra = rsqrtf(sa * (1.0f / 1024.0f) + 1e-6f), rb = rsqrtf(sb * (1.0f / 1024.0f) + 1e-6f);
    if (MODE == 0) {
      const int mia = mod_index(row), mib = mod_index(rowb);
      if (mia != cmi) { cmi = mia; const float* ma = mod + (size_t)mia * 6144;
#pragma unroll
        for (int i = 0; i < 4; ++i) { scv[i] = *(const f32x4*)(ma + sc_off + i * 256 + lane * 4) + 1.0f; shv[i] = *(const f32x4*)(ma + sh_off + i * 256 + lane * 4); } }
      f32x4 scb[4], shb[4];
#pragma unroll
      for (int i = 0; i < 4; ++i) { scb[i] = scv[i]; shb[i] = shv[i]; }
      if (mib != mia) { const float* mb = mod + (size_t)mib * 6144;
#pragma unroll
        for (int i = 0; i < 4; ++i) { scb[i] = *(const f32x4*)(mb + sc_off + i * 256 + lane * 4) + 1.0f; shb[i] = *(const f32x4*)(mb + sh_off + i * 256 + lane * 4); } }
#pragma unroll
      for (int i = 0; i < 4; ++i) { const int cc = i * 256 + lane * 4;
        const f32x4 oa = va[i] * ra * gv[i] * scv[i] + shv[i], ob = vb[i] * rb * gv[i] * scb[i] + shb[i];
        u32x2 pa, pb; pa[0] = cvt_pk_bf16(oa[0], oa[1]); pa[1] = cvt_pk_bf16(oa[2], oa[3]); pb[0] = cvt_pk_bf16(ob[0], ob[1]); pb[1] = cvt_pk_bf16(ob[2], ob[3]);
        *(u32x2*)(dst + (size_t)row * DM + cc) = pa; if (rowb != row) *(u32x2*)(dst + (size_t)rowb * DM + cc) = pb; }
    } else {
#pragma unroll
      for (int i = 0; i < 4; ++i) { const int cc = i * 256 + lane * 4;
        *(f32x4*)(fout + (size_t)row * DM + cc) = va[i] * ra * gv[i]; if (rowb != row) *(f32x4*)(fout + (size_t)rowb * DM + cc) = vb[i] * rb * gv[i]; }
    }
  }
}

__device__ __forceinline__ unsigned cvt_pk_bf16_p(float lo, float hi) { return cvt_pk_bf16(lo, hi); }
__device__ __forceinline__ float fsigmoid(float x) { return __builtin_amdgcn_rcpf(1.0f + __expf(-x)); }
constexpr int AVP = 136;
constexpr int KBP = 1040, VVP = 528;
constexpr int SC_AV = 0, SC_KB = 128 * AVP, SC_WW = SC_KB + 16 * KBP, SC_VV = SC_WW + 4096, SC_CC = SC_VV + 16 * VVP, SC_BUFB = SC_CC + 2048;
constexpr int SC_YB = 2 * SC_BUFB;
constexpr int GSP = 32 * AVP;
constexpr int SC_GS = SC_YB + 16640;
constexpr int SC_WT = SC_GS + 4 * GSP;
constexpr int SC_CT = SC_WT + 2 * 64 * 144;
constexpr int SC_END = SC_CT + 1280;
struct CSetP { u32x4 A0, A1, A2, A3; };
struct PLoad { bf16x8 a00, a01, a10, a11; u32x4 k[2], r[2]; };
template <int DIR>
__device__ void scan_unit(const Params& p, LAS unsigned char* lds, int h, int half, int tb0, int n0, const float* s0,
                          int tb1, int tbstride, int n1, int nseg1, float* so1, size_t sostride, bf16_t* ydst, bool bgconv) {
  constexpr int dir = DIR;
  const int tid = opaque_tid(), lane = tid & 63, wid = __builtin_amdgcn_readfirstlane(tid >> 6);
  const int c = lane & 15, q = lane >> 4;
  const int nch = n0 + n1 * nseg1;
#define SC_TB(g_) (((g_) < n0) ? (tb0 + (DIR ? (n0 - 1 - (g_)) : (g_)) * 64) \
                               : (tb1 + (((g_) - n0) / n1) * tbstride + (DIR ? (n1 - 1 - (((g_) - n0) % n1)) : (((g_) - n0) % n1)) * 64))
  if (wid < 2) {
    __builtin_amdgcn_s_setprio(3);
    const int rowl = wid * 16 + c, rg = half * 32 + rowl;
    f32x4 acc0, acc1, acc2, acc3;
    if (s0 && n0 > 0) { const float* sp = s0 + rg * 64 + 4 * q; acc0 = *(const f32x4*)(sp); acc1 = *(const f32x4*)(sp + 16); acc2 = *(const f32x4*)(sp + 32); acc3 = *(const f32x4*)(sp + 48); }
    else { acc0 = acc1 = acc2 = acc3 = (f32x4){0.f, 0.f, 0.f, 0.f}; }
    CSetP SA, SB;
    for (int ci = 0; ci < nch; ++ci) {
      __syncthreads();
      if (ci >= n0 && ci > 0 && ((ci - n0) % n1) == 0) acc0 = acc1 = acc2 = acc3 = (f32x4){0.f, 0.f, 0.f, 0.f};
      LAS unsigned char* B = lds + (ci & 1) * SC_BUFB;
      LAS float* yb = (LAS float*)(lds + SC_YB) + (ci & 1) * (32 * 65) + rowl * 65;
      LAS unsigned char* pA = B + SC_AV + (c & 3) * AVP + 8 * q;
      LAS unsigned char* pW = B + SC_WW + 16 * q;
      LAS unsigned char* pK = B + SC_KB + 16 * c;
      LAS unsigned char* pV = B + SC_VV + 16 * rowl;
      LAS unsigned char* pC = B + SC_CC;
      LAS unsigned char* pE = B + SC_CC + 512 + (c & 3) * 8;
      LAS unsigned char* pY = B + SC_CC + 1024 + (c & 3) * 16;
#define SC_RL(s_) (DIR ? (15 - (s_)) : (s_))
#define SC_LDP(o, rl_) do { const int _r = (rl_) * (8 * AVP); \
      { const u32x2 _x0 = *(const LAS u32x2*)(pA + _r), _x1 = *(const LAS u32x2*)(pA + _r + 32), _x2 = *(const LAS u32x2*)(pA + _r + 64), _x3 = *(const LAS u32x2*)(pA + _r + 96); \
        const u32x2 _x4 = *(const LAS u32x2*)(pA + _r + 4 * AVP), _x5 = *(const LAS u32x2*)(pA + _r + 4 * AVP + 32), _x6 = *(const LAS u32x2*)(pA + _r + 4 * AVP + 64), _x7 = *(const LAS u32x2*)(pA + _r + 4 * AVP + 96); \
        o.A0[0] = _x0[0]; o.A0[1] = _x0[1]; o.A0[2] = _x1[0]; o.A0[3] = _x1[1]; o.A1[0] = _x2[0]; o.A1[1] = _x2[1]; o.A1[2] = _x3[0]; o.A1[3] = _x3[1]; \
        o.A2[0] = _x4[0]; o.A2[1] = _x4[1]; o.A2[2] = _x5[0]; o.A2[3] = _x5[1]; o.A3[0] = _x6[0]; o.A3[1] = _x6[1]; o.A3[2] = _x7[0]; o.A3[3] = _x7[1]; } } while (0)
#define SC_ROUND(C, N, ri_, rnx_) do { const int _rl = SC_RL(ri_); \
      SC_LDP(N, SC_RL(rnx_)); \
      const u32x4 K0 = *(const LAS u32x4*)(pK + _rl * KBP), K1 = *(const LAS u32x4*)(pK + _rl * KBP + 256), K2 = *(const LAS u32x4*)(pK + _rl * KBP + 512), K3 = *(const LAS u32x4*)(pK + _rl * KBP + 768); \
      const f32x4 vv = *(const LAS f32x4*)(pV + _rl * VVP); \
      const f32x4 e2a = *(const LAS f32x4*)(pC + _rl * 32), e2b = *(const LAS f32x4*)(pC + _rl * 32 + 16); \
      const u32x2 eva = *(const LAS u32x2*)(pE + _rl * 32); const u32x4 evy = *(const LAS u32x4*)(pY + _rl * 64); \
      asm volatile("" ::: "memory"); \
        \
      u32x4 b0, b1; \
      b0[0] = cvt_pk_bf16_p(acc0[0], acc0[1]); b0[1] = cvt_pk_bf16_p(acc0[2], acc0[3]); b0[2] = cvt_pk_bf16_p(acc1[0], acc1[1]); b0[3] = cvt_pk_bf16_p(acc1[2], acc1[3]); \
      const f32x4 zz = {0.f, 0.f, 0.f, 0.f}; \
      f32x4 dA = __builtin_amdgcn_mfma_f32_16x16x32_bf16(__builtin_bit_cast(bf16x8, C.A0), __builtin_bit_cast(bf16x8, b0), zz, 0, 0, 0); \
      f32x4 dB = __builtin_amdgcn_mfma_f32_16x16x32_bf16(__builtin_bit_cast(bf16x8, C.A2), __builtin_bit_cast(bf16x8, b0), zz, 0, 0, 0); \
      b1[0] = cvt_pk_bf16_p(acc2[0], acc2[1]); b1[1] = cvt_pk_bf16_p(acc2[2], acc2[3]); b1[2] = cvt_pk_bf16_p(acc3[0], acc3[1]); b1[3] = cvt_pk_bf16_p(acc3[2], acc3[3]); \
      dA = __builtin_amdgcn_mfma_f32_16x16x32_bf16(__builtin_bit_cast(bf16x8, C.A1), __builtin_bit_cast(bf16x8, b1), dA, 0, 0, 0); \
      dB = __builtin_amdgcn_mfma_f32_16x16x32_bf16(__builtin_bit_cast(bf16x8, C.A3), __builtin_bit_cast(bf16x8, b1), dB, 0, 0, 0); \
      const float v1 = vv[0], v2 = vv[1], v3 = vv[2], v4 = vv[3]; \
      { const unsigned be0 = cvt_pk_bf16_p(v1, v2), be1 = cvt_pk_bf16_p(v3, v4); \
        const u32x4 bev = {(q == 0) ? be0 : 0u, (q == 0) ? be1 : 0u, 0u, 0u}; const u32x4 ae0 = {eva[0], eva[1], 0u, 0u}; \
          \
        dA = __builtin_amdgcn_mfma_f32_16x16x32_bf16(__builtin_bit_cast(bf16x8, ae0), __builtin_bit_cast(bf16x8, bev), dA, 0, 0, 0); } \
      const float psa1 = dA[0]; \
      const float psa2 = dA[1] + psa1 * e2a[0];     \
      const float psa3 = dA[2] + psa1 * e2a[1] + psa2 * e2a[2]; \
      const float psa4 = dA[3] + psa1 * e2a[3] + psa2 * e2b[0] + psa3 * e2b[1]; \
      u32x4 bbv; \
      { const unsigned bd1 = cvt_pk_bf16_p(v1, psa1), bd2 = cvt_pk_bf16_p(v2, psa2), bd3 = cvt_pk_bf16_p(v3, psa3), bd4 = cvt_pk_bf16_p(v4, psa4);     \
        bbv[0] = (q == 0) ? bd1 : 0u; bbv[1] = (q == 0) ? bd2 : 0u; bbv[2] = (q == 0) ? bd3 : 0u; bbv[3] = (q == 0) ? bd4 : 0u; } \
      const bf16x8 bb = __builtin_bit_cast(bf16x8, bbv); \
        \
      dB = __builtin_amdgcn_mfma_f32_16x16x32_bf16(__builtin_bit_cast(bf16x8, evy), bb, dB, 0, 0, 0); \
      acc0 = __builtin_amdgcn_mfma_f32_16x16x32_bf16(__builtin_bit_cast(bf16x8, K0), bb, acc0, 0, 0, 0); \
      acc1 = __builtin_amdgcn_mfma_f32_16x16x32_bf16(__builtin_bit_cast(bf16x8, K1), bb, acc1, 0, 0, 0); \
      acc2 = __builtin_amdgcn_mfma_f32_16x16x32_bf16(__builtin_bit_cast(bf16x8, K2), bb, acc2, 0, 0, 0); \
      acc3 = __builtin_amdgcn_mfma_f32_16x16x32_bf16(__builtin_bit_cast(bf16x8, K3), bb, acc3, 0, 0, 0); \
      { const float ya = (q & 1) ? dB[1] : dB[0], ybv = (q & 1) ? dB[3] : dB[2]; yb[DIR ? (4 * _rl + 3 - q) : (4 * _rl + q)] = (q & 2) ? ybv : ya; } \
      asm volatile("" ::: "memory"); __builtin_amdgcn_sched_barrier(0); } while (0)
      SC_LDP(SA, SC_RL(0));
      for (int g = 0; g < 8; ++g) {
        const int r0 = g * 2; const int rlast = (r0 + 2 < 16) ? (r0 + 2) : 15;
        f32x4 wt0, wt1, wt2, wt3;
        if (g & 1) { const int tl = SC_RL(r0) >> 2;
          wt0 = *(const LAS f32x4*)(pW + tl * 256); wt1 = *(const LAS f32x4*)(pW + tl * 256 + 64); wt2 = *(const LAS f32x4*)(pW + tl * 256 + 128); wt3 = *(const LAS f32x4*)(pW + tl * 256 + 192); }
        SC_ROUND(SA, SB, r0, r0 + 1);
        SC_ROUND(SB, SA, r0 + 1, rlast);
        if (g & 1) { acc0 *= wt0; acc1 *= wt1; acc2 *= wt2; acc3 *= wt3; }
      }
      if (ci >= n0 && ((ci - n0) % n1) == n1 - 1) {
        float* sp = so1 + (size_t)((ci - n0) / n1) * sostride + rg * 64 + 4 * q; *(f32x4*)(sp) = acc0; *(f32x4*)(sp + 16) = acc1; *(f32x4*)(sp + 32) = acc2; *(f32x4*)(sp + 48) = acc3; }
    }
    __syncthreads();
    __builtin_amdgcn_s_setprio(0);
#undef SC_LDP
#undef SC_ROUND
#undef SC_RL
  } else if (wid == 4 || wid == 5) {
    const int L = (wid - 4) * 64 + lane, ft = L >> 1, rh = L & 1;
    const bf16_t* Uq = (const bf16_t*)(p.ws + WS_U); bf16_t* CBq = (bf16_t*)(p.ws + WS_CB);
    float cw0[8], cw1[8], cw2[8];
    if (bgconv) {
#pragma unroll
      for (int i = 0; i < 8; ++i) { cw0[i] = p.in[21][L * 8 + i]; cw1[i] = p.in[21][1024 + L * 8 + i]; cw2[i] = p.in[21][2048 + L * 8 + i]; } }
    LAS float* tsc = (LAS float*)(lds + SC_TT) + (wid - 4) * 1056;
    const bf16_t* Vq = (const bf16_t*)(p.ws + WS_V);
#define FL_VVFILL(g_) do { const int _tb = SC_TB(g_); LAS unsigned char* _B = lds + ((g_) & 1) * SC_BUFB; const int _tl = L >> 1, _rh = L & 1; \
      const bf16_t* _vp = Vq + (size_t)(_tb + _tl) * DM + h * 64 + half * 32 + _rh * 16; const u32x4 _v0 = *(const u32x4*)(_vp), _v1 = *(const u32x4*)(_vp + 8); \
      const int _js = DIR ? (3 - (_tl & 3)) : (_tl & 3); LAS unsigned char* _wp = _B + SC_VV + (_tl >> 2) * VVP + ((_rh * 16) * 4 + _js) * 4; \
      _Pragma("unroll") for (int i = 0; i < 4; ++i) { *(LAS float*)(_wp + (2 * i) * 16) = lo_bf(_v0[i]); *(LAS float*)(_wp + (2 * i + 1) * 16) = hi_bf(_v0[i]); \
        *(LAS float*)(_wp + (8 + 2 * i) * 16) = lo_bf(_v1[i]); *(LAS float*)(_wp + (8 + 2 * i + 1) * 16) = hi_bf(_v1[i]); } } while (0)
    if (nch > 0) FL_VVFILL(0);
    for (int ci = 0; ci <= nch; ++ci) {
      __syncthreads();
      if (ci + 1 < nch) FL_VVFILL(ci + 1);
#define BG_TRANSPOSE(src_, srcN_, dst_, Kd_, jt_) do { const int _nkt = (Kd_) / 32; const int _o0 = ((jt_) / _nkt) * 32, _k0 = ((jt_) % _nkt) * 32; \
        { const int kr = lane >> 3, oc = (lane & 7) * 4; \
          _Pragma("unroll") for (int pz = 0; pz < 4; ++pz) { const f32x4 v = *(const f32x4*)((src_) + (size_t)(_k0 + kr + 8 * pz) * (srcN_) + _o0 + oc); \
            LAS float* tp = tsc + (kr + 8 * pz) * 33 + oc; tp[0] = v[0]; tp[1] = v[1]; tp[2] = v[2]; tp[3] = v[3]; } } \
        { const int oo = lane & 31, kh = lane >> 5; float w[16]; \
          _Pragma("unroll") for (int i = 0; i < 16; ++i) w[i] = tsc[(kh * 16 + i) * 33 + oo]; \
          u32x4 a, b2; \
          _Pragma("unroll") for (int i = 0; i < 4; ++i) { a[i] = cvt_pk_bf16(w[2 * i], w[2 * i + 1]); b2[i] = cvt_pk_bf16(w[8 + 2 * i], w[8 + 2 * i + 1]); } \
          bf16_t* dp = (dst_) + (size_t)(_o0 + oo) * (Kd_) + _k0 + kh * 16; *(u32x4*)(dp) = a; *(u32x4*)(dp + 8) = b2; } } while (0)
      if (bgconv && ci < 80 && (ci % 5) == 0) {
        const int job = (blockIdx.x * 2 + (wid - 4)) * 16 + ci / 5;
        const bool second = job >= 4096; const int jt = second ? job - 4096 : job;
        const float* src = second ? p.in[26] : p.in[25]; const int srcN = second ? 1024 : 4096, Kd = second ? 4096 : 1024;
        bf16_t* dstw = (bf16_t*)(p.ws + (second ? WS_WFF2 : WS_WFF1));
        BG_TRANSPOSE(src, srcN, dstw, Kd, jt);
      }
      if (bgconv && ci < 35 && (ci % 5) == 2) {
        const int job = (blockIdx.x * 2 + (wid - 4)) * 7 + ci / 5;
        if (job < 3072) { const int which = job >> 10, jt = job & 1023;
          const float* src = (which == 0) ? p.in[22] : (which == 1) ? p.in[23] : p.in[24];
          bf16_t* dstw = (bf16_t*)(p.ws + WS_WPA) + (size_t)which * 1024 * 1024;
          BG_TRANSPOSE(src, 1024, dstw, 1024, jt);
        } else if (job < 3200) { const int jt = job - 3072;
          BG_TRANSPOSE(p.in[15], 1024, (bf16_t*)(p.ws + WS_G2T), 128, jt); }
      }
#undef BG_TRANSPOSE
      if (bgconv && ci < 80) {
        const int tok = blockIdx.x * 80 + ci; const int Wm = (tok < NCTX) ? 255 : 63; const int pos = tok & Wm;
        const size_t off = (size_t)tok * DM + L * 8;
        const u32x4 uc = *(const u32x4*)(Uq + off), cbv = *(const u32x4*)(CBq + off);
        u32x4 up = {0u, 0u, 0u, 0u}, un = {0u, 0u, 0u, 0u};
        if (pos != 0) up = *(const u32x4*)(Uq + off - DM);
        if (pos != Wm) un = *(const u32x4*)(Uq + off + DM);
        float o[8];
#pragma unroll
        for (int i = 0; i < 4; ++i) {
          o[2 * i] = lo_bf(cbv[i]) * (cw0[2 * i] * lo_bf(up[i]) + cw1[2 * i] * lo_bf(uc[i]) + cw2[2 * i] * lo_bf(un[i]));
          o[2 * i + 1] = hi_bf(cbv[i]) * (cw0[2 * i + 1] * hi_bf(up[i]) + cw1[2 * i + 1] * hi_bf(uc[i]) + cw2[2 * i + 1] * hi_bf(un[i]));
        }
        u32x4 ob; ob[0] = cvt_pk_bf16(o[0], o[1]); ob[1] = cvt_pk_bf16(o[2], o[3]); ob[2] = cvt_pk_bf16(o[4], o[5]); ob[3] = cvt_pk_bf16(o[6], o[7]);
        *(u32x4*)(CBq + off) = ob;
      }
      if (ci >= 1) {
        const int cj = ci - 1, tb = SC_TB(cj);
        const LAS float* yb = (const LAS float*)(lds + SC_YB) + (cj & 1) * (32 * 65) + (rh * 16) * 65 + ft;
        float yv[16];
#pragma unroll
        for (int i = 0; i < 16; ++i) yv[i] = yb[i * 65];
        u32x4 o0, o1;
#pragma unroll
        for (int i = 0; i < 4; ++i) { o0[i] = cvt_pk_bf16(yv[2 * i], yv[2 * i + 1]); o1[i] = cvt_pk_bf16(yv[8 + 2 * i], yv[8 + 2 * i + 1]); }
        bf16_t* dp = ydst + (size_t)(tb + ft) * DM + h * 64 + half * 32 + rh * 16;
        *(u32x4*)(dp) = o0; *(u32x4*)(dp + 8) = o1;
      }
    }
  } else {
    const int pw = (wid & 1) + ((wid >> 2) << 1), t0 = pw * 16;
    const bf16_t* Rr = (const bf16_t*)(p.ws + WS_R); const bf16_t* Kr = (const bf16_t*)(p.ws + WS_K); const bf16_t* Vr = (const bf16_t*)(p.ws + WS_V);
    const bf16_t* LOR = (const bf16_t*)(p.ws + WS_LOR);
    float* C3 = (float*)(p.ws + WS_C3);
    LAS float* CT = (LAS float*)(lds + SC_CT);
    LAS unsigned char* WT = lds + SC_WT;
    LAS unsigned char* GS = lds + SC_GS + pw * GSP;
    { const int ch = h * 64 + lane;
      CT[lane] = p.in[11][dir * 1024 + ch]; CT[64 + lane] = p.in[13][dir * 1024 + ch]; CT[128 + lane] = p.in[16][ch]; CT[192 + lane] = p.in[17][ch]; CT[256 + lane] = p.in[18][ch];
#pragma unroll 2
      for (int i = 0; i < 16; ++i) { const int e = i * 64 + lane; const int sel = e >> 9, row = (e >> 3) & 63, seg = e & 7;
        const u32x4 wv = *(const u32x4*)((const bf16_t*)(p.ws + (sel ? WS_A2T : WS_W2T)) + ((size_t)(dir * 1024 + h * 64 + row)) * 64 + seg * 8);
        *(LAS u32x4*)(WT + (sel * 64 + row) * 144 + seg * 16) = wv; } }
    const int js = DIR ? (3 - (c & 3)) : (c & 3);
#define SC_PLD_A(o, ci_) do { const size_t _tok = (size_t)(SC_TB(ci_) + t0 + c); \
      const bf16_t* _ap = LOR + _tok * 384 + dir * 64 + q * 8; \
      o.a00 = *(const bf16x8*)(_ap); o.a01 = *(const bf16x8*)(_ap + 32); o.a10 = *(const bf16x8*)(_ap + 128); o.a11 = *(const bf16x8*)(_ap + 160); } while (0)
#define SC_PLD_K(o, ci_) do { const size_t _tok = (size_t)(SC_TB(ci_) + t0 + c); \
      const size_t _to = _tok * DM + h * 64; \
      o.k[0] = *(const u32x4*)(Kr + _to + q * 16); o.k[1] = *(const u32x4*)(Kr + _to + q * 16 + 8); o.r[0] = *(const u32x4*)(Rr + _to + q * 16); o.r[1] = *(const u32x4*)(Rr + _to + q * 16 + 8); } while (0)
    PLoad cur; SC_PLD_A(cur, 0); SC_PLD_K(cur, 0);
    for (int ci = 0; ci < nch; ++ci) {
      const int tb = SC_TB(ci);
      LAS unsigned char* B = lds + (ci & 1) * SC_BUFB;
      const int cn = (ci + 1 < nch) ? (ci + 1) : ci;
      const int t = t0 + c, rho = t >> 2;
      float ss = 0.f, c1 = 0.f, c2 = 0.f, c3 = 0.f;
      f32x4 decr[4], avr[4], kkr4[4], kdr4[4], rfr4[4];
#pragma unroll
      for (int nt = 0; nt < 4; ++nt) {
        const int wrow = (c >> 2) * 16 + nt * 4 + (c & 3);
        const bf16x8 w0f = *(const LAS bf16x8*)(WT + wrow * 144 + q * 16), w1f = *(const LAS bf16x8*)(WT + wrow * 144 + 64 + q * 16);
        const bf16x8 a0f = *(const LAS bf16x8*)(WT + (64 + wrow) * 144 + q * 16), a1f = *(const LAS bf16x8*)(WT + (64 + wrow) * 144 + 64 + q * 16);
        f32x4 X = {0.f, 0.f, 0.f, 0.f}, Y = {0.f, 0.f, 0.f, 0.f};
        X = __builtin_amdgcn_mfma_f32_16x16x32_bf16(w0f, cur.a00, X, 0, 0, 0); X = __builtin_amdgcn_mfma_f32_16x16x32_bf16(w1f, cur.a01, X, 0, 0, 0);
        Y = __builtin_amdgcn_mfma_f32_16x16x32_bf16(a0f, cur.a10, Y, 0, 0, 0); Y = __builtin_amdgcn_mfma_f32_16x16x32_bf16(a1f, cur.a11, Y, 0, 0, 0);
        const int kb = q * 16 + nt * 4;
        const f32x4 tw0 = *(const LAS f32x4*)(CT + kb), ta0 = *(const LAS f32x4*)(CT + 64 + kb), tkk = *(const LAS f32x4*)(CT + 128 + kb), tka = *(const LAS f32x4*)(CT + 192 + kb), trk = *(const LAS f32x4*)(CT + 256 + kb);
        const unsigned kq0 = cur.k[nt >> 1][(nt & 1) * 2], kq1 = cur.k[nt >> 1][(nt & 1) * 2 + 1], rq0 = cur.r[nt >> 1][(nt & 1) * 2], rq1 = cur.r[nt >> 1][(nt & 1) * 2 + 1];
        const float kf[4] = {lo_bf(kq0), hi_bf(kq0), lo_bf(kq1), hi_bf(kq1)};
        const float rf[4] = {lo_bf(rq0), hi_bf(rq0), lo_bf(rq1), hi_bf(rq1)};
#pragma unroll
        for (int j = 0; j < 4; ++j) {
          decr[nt][j] = __expf(-0.6065306597126334f * fsigmoid(tw0[j] + X[j]));
          const float av = fsigmoid(ta0[j] + Y[j]); avr[nt][j] = av;
          const float kr_ = kf[j] * tkk[j]; ss += kr_ * kr_;
          const float kd = kf[j] * (1.0f + (av - 1.0f) * tka[j]);
          kkr4[nt][j] = kr_; kdr4[nt][j] = kd; rfr4[nt][j] = rf[j];
          c1 += kd * rf[j]; c3 += rf[j] * kd * trk[j];
        }
      }
      SC_PLD_A(cur, cn);
      ss += __shfl_xor(ss, 16); ss += __shfl_xor(ss, 32);
      const float inv = rsqrtf(fmaxf(ss, 1e-12f));
#pragma unroll
      for (int nt = 0; nt < 4; ++nt) {
        const int kb = q * 16 + nt * 4;
        const f32x4 rf = rfr4[nt];
        float kkt[4], wrt[4], kdt[4], bt[4]; f32x4 pin;
#pragma unroll
        for (int j = 0; j < 4; ++j) {
          const float dec = decr[nt][j], av = avr[nt][j];
          const float kk = kkr4[nt][j] * inv, bv = -(kk * av), kd = kdr4[nt][j];
          c2 += bv * rf[j];
          float Pin = dec;
          Pin *= DIR ? dppo<0x101>(1.0f, Pin) : dppo<0x111>(1.0f, Pin);
          Pin *= DIR ? dppo<0x102>(1.0f, Pin) : dppo<0x112>(1.0f, Pin);
          Pin *= DIR ? dppo<0x104>(1.0f, Pin) : dppo<0x114>(1.0f, Pin);
          Pin *= DIR ? dppo<0x108>(1.0f, Pin) : dppo<0x118>(1.0f, Pin);
          const float Pex = DIR ? dppo<0x101>(1.0f, Pin) : dppo<0x111>(1.0f, Pin);
          const float rP = __builtin_amdgcn_rcpf(Pin);
          kkt[j] = kk * Pex; wrt[j] = rf[j] * Pin; kdt[j] = kd * rP; bt[j] = bv * rP; pin[j] = Pin;
          *(LAS unsigned*)(B + SC_KB + rho * KBP + ((kb + j) * 4 + js) * 4) = cvt_pk_bf16(kdt[j], bt[j]);
        }
        { u32x2 o; o[0] = cvt_pk_bf16(kkt[0], kkt[1]); o[1] = cvt_pk_bf16(kkt[2], kkt[3]); *(LAS u32x2*)(B + SC_AV + (rho * 8 + js) * AVP + kb * 2) = o; }
        { u32x2 o; o[0] = cvt_pk_bf16(wrt[0], wrt[1]); o[1] = cvt_pk_bf16(wrt[2], wrt[3]); *(LAS u32x2*)(B + SC_AV + (rho * 8 + 4 + js) * AVP + kb * 2) = o; }
        { u32x2 o; o[0] = cvt_pk_bf16(kdt[0], kdt[1]); o[1] = cvt_pk_bf16(kdt[2], kdt[3]); *(LAS u32x2*)(GS + (c * 2 + 0) * AVP + kb * 2) = o; }
        { u32x2 o; o[0] = cvt_pk_bf16(bt[0], bt[1]); o[1] = cvt_pk_bf16(bt[2], bt[3]); *(LAS u32x2*)(GS + (c * 2 + 1) * AVP + kb * 2) = o; }
        if ((DIR ? (15 - c) : c) == 15) *(LAS f32x4*)(B + SC_WW + (pw * 64 + kb) * 4) = pin;
      }
      c1 += __shfl_xor(c1, 16); c1 += __shfl_xor(c1, 32); c2 += __shfl_xor(c2, 16); c2 += __shfl_xor(c2, 32); c3 += __shfl_xor(c3, 16); c3 += __shfl_xor(c3, 32);
      LAS float* cp = (LAS float*)(B + SC_CC + rho * 32);
      LAS unsigned short* eva = (LAS unsigned short*)(B + SC_CC + 512 + rho * 32);
      LAS unsigned short* evy = (LAS unsigned short*)(B + SC_CC + 1024 + rho * 64);
      if (q == 0 && half == 0) C3[((size_t)dir * NT + tb + t) * 16 + h] = c3;
      { const LAS unsigned char* ap = B + SC_AV + (rho * 8 + js) * AVP + 16 * q;
        const LAS unsigned char* gp = GS + (c * 2) * AVP + 16 * q;
#define SC_LD16(p_) ({ const u32x2 _a = *(const LAS u32x2*)(p_), _b = *(const LAS u32x2*)((p_) + 8); const u32x4 _v = {_a[0], _a[1], _b[0], _b[1]}; __builtin_bit_cast(bf16x8, _v); })
        const bf16x8 akk0 = SC_LD16(ap), akk1 = SC_LD16(ap + 64), awr0 = SC_LD16(ap + 4 * AVP), awr1 = SC_LD16(ap + 4 * AVP + 64);
        const bf16x8 bkd0 = SC_LD16(gp), bkd1 = SC_LD16(gp + 64), bb0 = SC_LD16(gp + AVP), bb1 = SC_LD16(gp + AVP + 64);
#undef SC_LD16
        const f32x4 zz = {0.f, 0.f, 0.f, 0.f};
        f32x4 gE1 = __builtin_amdgcn_mfma_f32_16x16x32_bf16(akk0, bkd0, zz, 0, 0, 0); gE1 = __builtin_amdgcn_mfma_f32_16x16x32_bf16(akk1, bkd1, gE1, 0, 0, 0);
        f32x4 gE2 = __builtin_amdgcn_mfma_f32_16x16x32_bf16(akk0, bb0, zz, 0, 0, 0);  gE2 = __builtin_amdgcn_mfma_f32_16x16x32_bf16(akk1, bb1, gE2, 0, 0, 0);
        f32x4 gF1 = __builtin_amdgcn_mfma_f32_16x16x32_bf16(awr0, bkd0, zz, 0, 0, 0); gF1 = __builtin_amdgcn_mfma_f32_16x16x32_bf16(awr1, bkd1, gF1, 0, 0, 0);
        f32x4 gF2 = __builtin_amdgcn_mfma_f32_16x16x32_bf16(awr0, bb0, zz, 0, 0, 0);  gF2 = __builtin_amdgcn_mfma_f32_16x16x32_bf16(awr1, bb1, gF2, 0, 0, 0);
        if (q == (c >> 2)) {
#pragma unroll
          for (int jj = 0; jj < 4; ++jj) { const int jsj = DIR ? (3 - jj) : jj;
            const float eE = (jsj > js) ? gE1[jj] : 0.f;
            const float eFv = (jsj > js) ? gF1[jj] : ((jsj == js) ? c1 : 0.f);
            const float eFp = (jsj > js) ? gF2[jj] : ((jsj == js) ? c2 : 0.f);
            eva[jsj * 4 + js] = (unsigned short)(cvt_pk_bf16(eE, 0.f) & 0xffffu);
            *(LAS unsigned*)(evy + jsj * 8 + 2 * js) = cvt_pk_bf16(eFv, eFp);
            if (jsj > js) { const int idx = jsj * (jsj - 1) / 2 + js; cp[idx] = gE2[jj]; } }
        }
      }
      SC_PLD_K(cur, cn);
      __syncthreads();
    }
    __syncthreads();
#undef SC_PLD_A
#undef SC_PLD_K
  }
  __syncthreads();
#undef SC_TB
}

#define XB_TMO      128
#define XB_XCNT(j)  (256  + 64 * (j))
#define XB_XSUB(j)  (1280 + 64 * (j))
#define XB_XGEN(j)  (2304 + 64 * (j))
#define XB_TOP      3328
#define XB_TOPGEN   3392
#define XCD_BAR_WORDS 3456
#define XB_SPIN_CAP (1u << 18)
__device__ __forceinline__ unsigned xb_ld(unsigned* p)              { return __hip_atomic_load(p, __ATOMIC_RELAXED, __HIP_MEMORY_SCOPE_AGENT); }
__device__ __forceinline__ unsigned xb_add(unsigned* p, unsigned v) { return __hip_atomic_fetch_add(p, v, __ATOMIC_RELAXED, __HIP_MEMORY_SCOPE_AGENT); }
__device__ __forceinline__ unsigned xb_xcc_id() { return (unsigned)__builtin_amdgcn_s_getreg((3 << 11) | 20) & 0xFu; }
#define XB_SPIN(cond, bar) do { unsigned _sp = 0; while (cond) { __builtin_amdgcn_s_sleep(1); \
    if ((++_sp & 255u) == 0u) { if (xb_ld(&(bar)[XB_TMO])) break; if (_sp > XB_SPIN_CAP) { atomicAdd(&(bar)[XB_TMO], 1u); break; } } } } while (0)
struct XcdBarrier { unsigned* bar; unsigned x; volatile LAS unsigned* st; };
__device__ __forceinline__ XcdBarrier xcd_barrier_post(unsigned* bar, volatile LAS unsigned* st) {
  XcdBarrier b; b.bar = bar; b.x = xb_xcc_id(); b.st = st;
  if (threadIdx.x == 0) (void)xb_add(&bar[XB_XCNT(b.x)], 1u);
  return b;
}
__device__ __forceinline__ void xcd_barrier_complete(unsigned* bar, unsigned x, unsigned& nloc, unsigned& nx) {
  const unsigned G = gridDim.x * gridDim.y * gridDim.z;
  unsigned sum, cnt, mine, sp = 0u;
  for (;;) {
    sum = 0u; cnt = 0u; mine = 0u;
#pragma unroll
    for (unsigned j = 0; j < 16; ++j) { const unsigned c = xb_ld(&bar[XB_XCNT(j)]); sum += c; cnt += (c > 0u) ? 1u : 0u; mine = (j == x) ? c : mine; }
    if (sum == G) break;
    __builtin_amdgcn_s_sleep(1);
    if ((++sp & 255u) == 0u) { if (xb_ld(&bar[XB_TMO])) break; if (sp > XB_SPIN_CAP) { atomicAdd(&bar[XB_TMO], 1u); break; } }
  }
  nloc = mine > 0u ? mine : 1u; nx = cnt > 0u ? cnt : 1u;
}
__device__ __forceinline__ void xcd_barrier(const XcdBarrier& b) {
  asm volatile("s_waitcnt vmcnt(0)" ::: "memory");
  __syncthreads();
  if (threadIdx.x == 0) {
    unsigned* bar = b.bar;
    __builtin_amdgcn_s_waitcnt(0);
    unsigned nloc = b.st[0], nx = b.st[1];
    if (nloc == 0u) { xcd_barrier_complete(bar, b.x, nloc, nx); b.st[0] = nloc; b.st[1] = nx; }
    const unsigned old = xb_add(&bar[XB_XSUB(b.x)], 1u);
    const unsigned gen = old / nloc;
    if (old + 1u == (gen + 1u) * nloc) {
      __builtin_amdgcn_fence(__ATOMIC_RELEASE, "agent");
      asm volatile("s_waitcnt vmcnt(0)" ::: "memory");
      const unsigned og = xb_add(&bar[XB_TOP], 1u);
      const unsigned tg = og / nx;
      if (og + 1u == (tg + 1u) * nx) xb_add(&bar[XB_TOPGEN], 1u);
      else XB_SPIN(xb_ld(&bar[XB_TOPGEN]) == tg, bar);
      __builtin_amdgcn_fence(__ATOMIC_ACQUIRE, "agent");
      xb_add(&bar[XB_XGEN(b.x)], 1u);
      asm volatile("s_waitcnt vmcnt(0)" ::: "memory");
    } else {
      XB_SPIN(xb_ld(&bar[XB_XGEN(b.x)]) == gen, bar);
      __builtin_amdgcn_fence(__ATOMIC_ACQUIRE, "agent");
      asm volatile("s_waitcnt vmcnt(0)" ::: "memory");
    }
  }
  __syncthreads();
}

__global__ void __launch_bounds__(512, 2) mega(Params p) {
  extern __shared__ __attribute__((aligned(16))) unsigned char lds_raw[];
  LAS unsigned char* lds = (LAS unsigned char*)lds_raw;
  cg::grid_group grid = cg::this_grid();
  unsigned char* ws = p.ws;
  bf16_t* const rR = (bf16_t*)(ws + WS_R); bf16_t* const rK = (bf16_t*)(ws + WS_K); bf16_t* const rCB = (bf16_t*)(ws + WS_CB);
  bf16_t* const rU = (bf16_t*)(ws + WS_U); bf16_t* const rV = (bf16_t*)(ws + WS_V); bf16_t* const rLOR = (bf16_t*)(ws + WS_LOR);
  bf16_t* const D0 = (bf16_t*)p.out; bf16_t* const D1 = (bf16_t*)((unsigned char*)p.out + RG);
  float* const MODP = (float*)(ws + WS_MODP); float* const MOD = (float*)(ws + WS_MOD);
  const float* xp = p.in[0]; const float* xs = p.in[1];
  pg8::StaticOrder S;
  volatile LAS unsigned* xst = (volatile LAS unsigned*)(lds + XST_OFF);
  if (threadIdx.x < 4) xst[threadIdx.x] = 0u;
  __syncthreads();
  const XcdBarrier xb = xcd_barrier_post((unsigned*)(ws + WS_BAR), xst);

  for (int rep = 0; rep < REP_P0; ++rep) {
    const int tid = opaque_tid();
    LAS float* tile = (LAS float*)lds;
    transpose_job<true>(tile, p.in[10], 8576, (bf16_t*)(ws + WS_WIN), 8704, 1024);
    if (gridDim.x != 256) {
    transpose_job<false>(tile, p.in[22], 1024, (bf16_t*)(ws + WS_WPA), 1024, 1024);
    transpose_job<false>(tile, p.in[23], 1024, (bf16_t*)(ws + WS_WPB), 1024, 1024);
    transpose_job<false>(tile, p.in[24], 1024, (bf16_t*)(ws + WS_WO), 1024, 1024);
    transpose_job<false>(tile, p.in[15], 1024, (bf16_t*)(ws + WS_G2T), 1024, 128); }
    for (int d = 0; d < 2; ++d) {
      transpose_job<false>(tile, p.in[12] + (size_t)d * 64 * 1024, 1024, (bf16_t*)(ws + WS_W2T) + (size_t)d * 1024 * 64, 1024, 64);
      transpose_job<false>(tile, p.in[14] + (size_t)d * 64 * 1024, 1024, (bf16_t*)(ws + WS_A2T) + (size_t)d * 1024 * 64, 1024, 64);
    }
    LAS float* sl = (LAS float*)lds;
    for (int ib = blockIdx.x; ib < 32 * 12; ib += gridDim.x) {
      const int kc = ib / 12, j = (ib % 12) * 512 + tid;
      __syncthreads();
      if (tid < 160) { const int i = tid >> 5, k = kc * 32 + (tid & 31); const float c = (i == 0) ? p.in[5][k] : p.in[4][(i - 1) * 1024 + k]; sl[tid] = c / (1.0f + __expf(-c)); }
      __syncthreads();
      float s[5] = {0.f, 0.f, 0.f, 0.f, 0.f};
      const float* wp = p.in[8] + (size_t)(kc * 32) * 6144 + j;
#pragma unroll 8
      for (int k = 0; k < 32; ++k) { const float w = wp[(size_t)k * 6144];
#pragma unroll
        for (int i = 0; i < 5; ++i) s[i] += sl[i * 32 + k] * w; }
#pragma unroll
      for (int i = 0; i < 5; ++i) MODP[((size_t)kc * 5 + i) * 6144 + j] = s[i];
    }
  }
  if (p.ws == nullptr) grid.sync();
  xcd_barrier(xb);
  for (int idx = blockIdx.x * 512 + opaque_tid(); idx < 5 * 6144; idx += gridDim.x * 512) {
    const int j = idx % 6144; float s = p.in[9][j];
    for (int kc = 0; kc < 32; ++kc) s += MODP[(size_t)kc * 5 * 6144 + idx];
    MOD[idx] = s;
  }
  xcd_barrier(xb);
  norm_rows<0>(xp, xs, p.in[6], MOD, 0, 1024, D0, nullptr);
  xcd_barrier(xb);
  { pg8::Gemm g{D0, (const bf16_t*)(ws + WS_WIN), NT, 6656, 1024, 1024}; S.init(NT, 6656, gridDim.x, blockIdx.x);
    EpiIn E{rR, rK, rV, rCB, rU, rLOR}; pg8::gemm_phase(lds, g, S, E); }
  xcd_barrier(xb);
  {
    const bool stream = (gridDim.x == 256);
    for (int u = blockIdx.x; u < (stream ? 256 : 256 + 1024); u += gridDim.x) {
      int h, dir, half, tb0 = 0, n0 = 0, tb1 = 0, tbs = 0, ns1 = 0; const float* s0 = nullptr; float* so1 = nullptr; size_t sos = 0;
      if (u < 256) { const int b = u >> 6; h = (u >> 2) & 15; dir = (u >> 1) & 1; half = u & 1;
        tb0 = NCTX + b * 4096; n0 = 64; s0 = p.in[2 + dir] + (size_t)(b * 16 + h) * 4096;
        if (stream) { tb1 = b * 256; tbs = 4 * 256; ns1 = 4; sos = (size_t)4 * 16 * 4096;
          so1 = p.out + (size_t)NT * DM + (size_t)dir * (16 * 16 * 4096) + (size_t)(b * 16 + h) * 4096; }
      } else { const int cu = u - 256; const int b = cu >> 6; h = (cu >> 2) & 15; dir = (cu >> 1) & 1; half = cu & 1;
        tb1 = b * 256; ns1 = 1; so1 = p.out + (size_t)NT * DM + (size_t)dir * (16 * 16 * 4096) + (size_t)(b * 16 + h) * 4096; }
      if (dir) scan_unit<1>(p, lds, h, half, tb0, n0, s0, tb1, tbs, 4, ns1, so1, sos, D1, stream);
      else scan_unit<0>(p, lds, h, half, tb0, n0, s0, tb1, tbs, 4, ns1, so1, sos, D0, stream);
    }
  }
  xcd_barrier(xb);
  {
    const int tid = opaque_tid(), lane = tid & 63, wid = tid >> 6;
    const bf16_t* G2T = (const bf16_t*)(ws + WS_G2T); const float* C3 = (const float*)(ws + WS_C3);
    const int gw = blockIdx.x * 8 + wid, nw = gridDim.x * 8; const int tk = lane & 15, q = lane >> 4;
    const int tpw = (NT / 16 + gridDim.x - 1) / gridDim.x;
    for (int rep = 0; rep < REP_P7; ++rep)
    for (int e = 0; e < 2; ++e) {
      const int h = wid * 2 + e;
      bf16x8 gfr[4][4]; f32x4 lw[4], lb[4];
#pragma unroll
      for (int nt = 0; nt < 4; ++nt) { lw[nt] = *(const f32x4*)(p.in[19] + h * 64 + q * 16 + nt * 4); lb[nt] = *(const f32x4*)(p.in[20] + h * 64 + q * 16 + nt * 4);
#pragma unroll
        for (int ks = 0; ks < 4; ++ks) gfr[nt][ks] = *(const bf16x8*)(G2T + (size_t)(h * 64 + (tk >> 2) * 16 + nt * 4 + (tk & 3)) * 128 + ks * 32 + q * 8); }
      for (int k = 0; k < tpw; ++k) {
        const int tt = blockIdx.x * tpw + k; if (tt >= NT / 16) break;
        const int tok = tt * 16 + tk;
        bf16x8 sfr[4];
#pragma unroll
        for (int ks = 0; ks < 4; ++ks) sfr[ks] = *(const bf16x8*)(rLOR + (size_t)tok * 384 + 256 + ks * 32 + q * 8);
        const float c3s = C3[(size_t)tok * 16 + h] + C3[((size_t)NT + tok) * 16 + h];
        const size_t off = (size_t)tok * DM + h * 64 + q * 16;
        const u32x4 yfa = *(const u32x4*)(D0 + off), yfb = *(const u32x4*)(D0 + off + 8), yba = *(const u32x4*)(D1 + off), ybb = *(const u32x4*)(D1 + off + 8);
        const u32x4 va = *(const u32x4*)(rV + off), vb = *(const u32x4*)(rV + off + 8);
        f32x4 go[4]; float wkv[4][4], vv[4][4]; float sm = 0.f;
#pragma unroll
        for (int nt = 0; nt < 4; ++nt) {
          const unsigned yf0 = (nt < 2) ? yfa[2 * nt] : yfb[2 * nt - 4], yf1 = (nt < 2) ? yfa[2 * nt + 1] : yfb[2 * nt - 3];
          const unsigned yb0 = (nt < 2) ? yba[2 * nt] : ybb[2 * nt - 4], yb1 = (nt < 2) ? yba[2 * nt + 1] : ybb[2 * nt - 3];
          const unsigned v0 = (nt < 2) ? va[2 * nt] : vb[2 * nt - 4], v1 = (nt < 2) ? va[2 * nt + 1] : vb[2 * nt - 3];
          f32x4 z = {0.f, 0.f, 0.f, 0.f};
#pragma unroll
          for (int ks = 0; ks < 4; ++ks) z = __builtin_amdgcn_mfma_f32_16x16x32_bf16(gfr[nt][ks], sfr[ks], z, 0, 0, 0);
          go[nt] = z;
          wkv[nt][0] = lo_bf(yf0) + lo_bf(yb0); wkv[nt][1] = hi_bf(yf0) + hi_bf(yb0); wkv[nt][2] = lo_bf(yf1) + lo_bf(yb1); wkv[nt][3] = hi_bf(yf1) + hi_bf(yb1);
          vv[nt][0] = lo_bf(v0); vv[nt][1] = hi_bf(v0); vv[nt][2] = lo_bf(v1); vv[nt][3] = hi_bf(v1);
          sm += wkv[nt][0] + wkv[nt][1] + wkv[nt][2] + wkv[nt][3];
        }
        sm += __shfl_xor(sm, 16); sm += __shfl_xor(sm, 32);
        const float mu = sm * (1.0f / 64.0f); float s2 = 0.f;
#pragma unroll
        for (int nt = 0; nt < 4; ++nt)
#pragma unroll
          for (int j = 0; j < 4; ++j) { const float d = wkv[nt][j] - mu; s2 += d * d; }
        s2 += __shfl_xor(s2, 16); s2 += __shfl_xor(s2, 32);
        const float rs = rsqrtf(s2 * (1.0f / 64.0f) + 64e-5f);
        u32x4 oa, ob2;
#pragma unroll
        for (int nt = 0; nt < 4; ++nt) {
          float o[4];
#pragma unroll
          for (int j = 0; j < 4; ++j) o[j] = ((wkv[nt][j] - mu) * rs * lw[nt][j] + lb[nt][j] + c3s * vv[nt][j]) * go[nt][j];
          const unsigned p0 = cvt_pk_bf16(o[0], o[1]), p1 = cvt_pk_bf16(o[2], o[3]);
          if (nt < 2) { oa[2 * nt] = p0; oa[2 * nt + 1] = p1; } else { ob2[2 * nt - 4] = p0; ob2[2 * nt - 3] = p1; } }
        *(u32x4*)(rR + off) = oa; *(u32x4*)(rR + off + 8) = ob2;
      }
    }
    norm_rows<0>(xp, xs, p.in[6], MOD, 0, 1024, rK, nullptr);
    const float* cw = p.in[21];
    const int rpw = (NT + gridDim.x - 1) / gridDim.x;
    if (gridDim.x != 256) { const int c0 = (tid & 127) * 8;
      float w0[8], w1[8], w2[8];
#pragma unroll
      for (int i = 0; i < 8; ++i) { w0[i] = cw[c0 + i]; w1[i] = cw[1024 + c0 + i]; w2[i] = cw[2048 + c0 + i]; }
      for (int li = tid; li < rpw * 128; li += 512) {
        const int tok = blockIdx.x * rpw + (li >> 7); if (tok >= NT) break;
        const int Wm = (tok < NCTX) ? 255 : 63; const int pos = tok & Wm;
        const size_t off = (size_t)tok * DM + c0;
        const u32x4 uc = *(const u32x4*)(rU + off), cbv = *(const u32x4*)(rCB + off);
        u32x4 up = {0u, 0u, 0u, 0u}, un = {0u, 0u, 0u, 0u};
        if (pos != 0) up = *(const u32x4*)(rU + off - DM);
        if (pos != Wm) un = *(const u32x4*)(rU + off + DM);
        float o[8];
#pragma unroll
        for (int i = 0; i < 4; ++i) {
          o[2 * i] = lo_bf(cbv[i]) * (w0[2 * i] * lo_bf(up[i]) + w1[2 * i] * lo_bf(uc[i]) + w2[2 * i] * lo_bf(un[i]));
          o[2 * i + 1] = hi_bf(cbv[i]) * (w0[2 * i + 1] * hi_bf(up[i]) + w1[2 * i + 1] * hi_bf(uc[i]) + w2[2 * i + 1] * hi_bf(un[i]));
        }
        u32x4 ob; ob[0] = cvt_pk_bf16(o[0], o[1]); ob[1] = cvt_pk_bf16(o[2], o[3]); ob[2] = cvt_pk_bf16(o[4], o[5]); ob[3] = cvt_pk_bf16(o[6], o[7]);
        *(u32x4*)(rCB + off) = ob;
      }
    }
  }
  xcd_barrier(xb);
  { pg8::Gemm g{rK, (const bf16_t*)(ws + WS_WIN) + (size_t)6656 * 1024, NT, 3072, 1024, 1024, rCB, (const bf16_t*)(ws + WS_WPB), 8}; S.init(NT, 3072, gridDim.x, blockIdx.x);
    EpiGate E{D0, D1, rU}; pg8::gemm_phase(lds, g, S, E); }
  xcd_barrier(xb);
  { pg8::Gemm g{rR, (const bf16_t*)(ws + WS_WPA), NT, 1024, 1024, 1024}; S.init(NT, 1024, gridDim.x, blockIdx.x);
    EpiYa E{D0, D1, rU}; pg8::gemm_phase(lds, g, S, E); }
  xcd_barrier(xb);
  { pg8::Gemm g{rU, (const bf16_t*)(ws + WS_WO), NT, 1024, 1024, 1024}; S.init(NT, 1024, gridDim.x, blockIdx.x);
    EpiResB<true> E{xp, xs, nullptr, D0, MOD + 2048, 0}; pg8::gemm_phase(lds, g, S, E); }
  xcd_barrier(xb);
  norm_rows<0, true>(nullptr, nullptr, p.in[7], MOD, 3072, 4096, rV, nullptr, D0);
  if (gridDim.x != 256) { LAS float* tile = (LAS float*)lds;
    transpose_job<false>(tile, p.in[25], 4096, (bf16_t*)(ws + WS_WFF1), 4096, 1024);
    transpose_job<false>(tile, p.in[26], 1024, (bf16_t*)(ws + WS_WFF2), 1024, 4096); }
  xcd_barrier(xb);
  { pg8::Gemm g{rV, (const bf16_t*)(ws + WS_WFF1), NT, 4096, 1024, 1024}; S.init(NT, 4096, gridDim.x, blockIdx.x);
    EpiFf1 E{rR}; pg8::gemm_phase(lds, g, S, E);
#if REP_P12 > 1
    __syncthreads(); pg8::gemm_phase(lds, g, S, E);
#endif
  }
  xcd_barrier(xb);
  { pg8::Gemm g{rR, (const bf16_t*)(ws + WS_WFF2), 16384, 1024, 4096, 4096}; S.init(16384, 1024, gridDim.x, blockIdx.x);
    EpiResB<false> E{nullptr, nullptr, D0, rV, MOD + 5120, 0}; pg8::gemm_phase(lds, g, S, E); }
  { pg8::Gemm g{rR + (size_t)16384 * 4096, (const bf16_t*)(ws + WS_WFF2), 4096, 1024, 2048, 4096}; S.init(4096, 1024, gridDim.x, blockIdx.x, 2);
    EpiFf2Split E{D0, rV, MOD + 5120, (bf16_t*)(ws + WS_LOR), 16384}; pg8::gemm_phase(lds, g, S, E); }
  xcd_barrier(xb);
  norm_rows<1, true>(nullptr, nullptr, p.in[27], MOD, 5120, 0, (bf16_t*)(ws + WS_LOR), p.out, rV);
}

extern "C" void kernel_launch(void* const* d_in, const int* in_sizes, int n_in,
                              void* d_out, int out_size, void* d_ws, size_t ws_size,
                              hipStream_t stream) {
  static int grid_blocks = 0;
  if (!grid_blocks) {
    int dev = 0, cus = 0, per_cu = 0;
    (void)hipGetDevice(&dev);
    (void)hipDeviceGetAttribute(&cus, hipDeviceAttributeMultiprocessorCount, dev);
    (void)hipFuncSetAttribute((const void*)mega, hipFuncAttributeMaxDynamicSharedMemorySize, LDS_BYTES);
    (void)hipOccupancyMaxActiveBlocksPerMultiprocessor(&per_cu, (const void*)mega, 512, LDS_BYTES);
    if (per_cu < 1) { fprintf(stderr, "occupancy query reports %d blocks per CU\n", per_cu); per_cu = 1; }
    grid_blocks = cus;
    if (ws_size < WS_END + (size_t)8 * 1024 * 1024) fprintf(stderr, "workspace too small: %zu < %zu\n", ws_size, (size_t)WS_END);
  }
  Params p{};
  for (int i = 0; i < 28 && i < n_in; ++i) p.in[i] = (const float*)d_in[i];
  p.out = (float*)d_out;
  p.ws = (unsigned char*)d_ws;
  (void)hipMemsetAsync((unsigned char*)d_ws + WS_BAR, 0, (size_t)3456 * 4, stream);
  void* args[] = {&p};
  hipError_t e = hipLaunchCooperativeKernel((void*)mega, dim3(grid_blocks), dim3(512), args, LDS_BYTES, stream);
  if (e != hipSuccess) fprintf(stderr, "cooperative launch failed: %s (grid %d)\n", hipGetErrorString(e), grid_blocks);
}
```

```cpp
#include <hip/hip_runtime.h>
#include <hip/hip_cooperative_groups.h>
#include <cstdio>
namespace cg = cooperative_groups;

#define LAS __attribute__((address_space(3)))
typedef unsigned short bf16_t;
typedef short bf16x8 __attribute__((ext_vector_type(8)));
typedef float f32x4 __attribute__((ext_vector_type(4)));
typedef unsigned u32x4 __attribute__((ext_vector_type(4)));
typedef unsigned u32x2 __attribute__((ext_vector_type(2)));

constexpr int NT = 20480;
constexpr int NCTX = 4096;
constexpr int DM = 1024;
constexpr size_t RG = (size_t)NT * DM * 2;
constexpr size_t WS_R = 0, WS_K = RG, WS_CB = 2 * RG, WS_U = 3 * RG, WS_V = 4 * RG;
constexpr size_t WS_LOR = 5 * RG;
constexpr size_t WS_WIN = WS_LOR + (size_t)NT * 384 * 2;
constexpr size_t WS_WPA = WS_WIN + (size_t)8704 * 1024 * 2;
constexpr size_t WS_WPB = WS_WPA + (size_t)1024 * 1024 * 2;
constexpr size_t WS_WO = WS_WPB + (size_t)1024 * 1024 * 2;
constexpr size_t WS_W2T = WS_WO + (size_t)1024 * 1024 * 2;
constexpr size_t WS_A2T = WS_W2T + (size_t)2 * 1024 * 64 * 2;
constexpr size_t WS_G2T = WS_A2T + (size_t)2 * 1024 * 64 * 2;
constexpr size_t WS_MODP = WS_G2T + (size_t)1024 * 128 * 2;
constexpr size_t WS_MOD = WS_MODP + (size_t)32 * 5 * 6144 * 4;
constexpr size_t WS_C3 = WS_MOD + (size_t)5 * 6144 * 4;
constexpr size_t WS_BAR = WS_C3 + (size_t)2 * NT * 16 * 4;
constexpr size_t WS_END = WS_BAR + (size_t)3456 * 4;
constexpr size_t WS_WFF1 = WS_WIN, WS_WFF2 = WS_END;
constexpr int XST_OFF = 151040;
constexpr int SC_TT = XST_OFF + 16;
constexpr int LDS_BYTES = SC_TT + 2 * 4224;
#ifndef REP_SCAN
#define REP_SCAN 1
#endif
#ifndef REP_P2
#define REP_P2 1
#endif
#ifndef REP_P12
#define REP_P12 1
#endif
#ifndef REP_P7
#define REP_P7 1
#endif
#ifndef REP_P0
#define REP_P0 1
#endif


struct Params {
  const float* in[28];
  float* out;
  unsigned char* ws;
};

__device__ __forceinline__ float bf2f(unsigned b) { return __uint_as_float(b << 16); }
typedef __bf16 bf16v2_t __attribute__((ext_vector_type(2)));
typedef float f32v2_t __attribute__((ext_vector_type(2)));
__device__ __forceinline__ unsigned cvt_pk_bf16(float lo, float hi) { const f32v2_t f = {lo, hi}; const bf16v2_t r = __builtin_convertvector(f, bf16v2_t); return __builtin_bit_cast(unsigned, r); }
__device__ __forceinline__ float lo_bf(unsigned u) { return __uint_as_float(u << 16); }
__device__ __forceinline__ float hi_bf(unsigned u) { return __uint_as_float(u & 0xffff0000u); }
__device__ __forceinline__ float sigmoidf_(float x) { return __builtin_amdgcn_rcpf(1.0f + __expf(-x)); }
template <int CTRL> __device__ __forceinline__ float dppf(float x) {
  return __int_as_float(__builtin_amdgcn_update_dpp(0, __float_as_int(x), CTRL, 0xF, 0xF, true));
}
template <int CTRL> __device__ __forceinline__ float dppo(float oldv, float x) {
  return __int_as_float(__builtin_amdgcn_update_dpp(__float_as_int(oldv), __float_as_int(x), CTRL, 0xF, 0xF, false));
}
__device__ __forceinline__ float sum8(float x) { x += dppf<0xB1>(x); x += dppf<0x4E>(x); x += dppf<0x141>(x); return x; }
__device__ __forceinline__ float sum16(float x) { x = sum8(x); x += dppf<0x140>(x); return x; }
__device__ __forceinline__ float wave_sum(float x) {
  x = sum16(x); x += __shfl_xor(x, 16); x += __shfl_xor(x, 32); return x;
}
__device__ __forceinline__ int opaque_tid() { int t = threadIdx.x; asm volatile("" : "+v"(t)); return t; }
__device__ __forceinline__ __amdgpu_buffer_rsrc_t wt_rsrc(const void* base) { return __builtin_amdgcn_make_buffer_rsrc(const_cast<void*>(base), 0, 0x7fffffff, 0x00020000); }
__device__ __forceinline__ void st16_wt(const __amdgpu_buffer_rsrc_t& rs, const void* base, const void* p, u32x4 v) {
  __builtin_amdgcn_raw_buffer_store_b128(v, rs, (unsigned)((const char*)p - (const char*)base), 0, 16); }
__device__ __forceinline__ void st8_wt(const __amdgpu_buffer_rsrc_t& rs, const void* base, const void* p, u32x2 v) {
  __builtin_amdgcn_raw_buffer_store_b64(v, rs, (unsigned)((const char*)p - (const char*)base), 0, 16); }
__device__ __forceinline__ int mod_index(int row) { return row < NCTX ? 0 : 1 + ((row - NCTX) >> 12); }

namespace pg8 {
constexpr int BM = 256, BK = 64, HALF = 128, HTB = HALF * BK * 2, STAGE_BYTES = 8 * HTB, NXCD = 8, WGM = 8;
__device__ __forceinline__ int lds_byte(int r, int c) { const int st = (r >> 4) * 2 + (c >> 5), rr = r & 15, cc = c & 31, ob = rr * 64 + cc * 2; return st * 1024 + (ob ^ (((ob >> 9) & 1) << 5)); }
__device__ __forceinline__ void stage_rc(int b, int& R, int& C) { const int st = b / 1024, sb = b % 1024, swz = sb ^ (((sb >> 9) & 1) << 5); R = (st >> 1) * 16 + swz / 64; C = (st & 1) * 32 + (swz % 64) / 2; }
__device__ __forceinline__ int perm32(int rho) { const int n = rho >> 4, i = rho & 15; return 8 * (i >> 2) + 4 * n + (i & 3); }
struct Unit { int pm, pn, ks; };
struct Gemm { const bf16_t* A; const bf16_t* Bt; int M, N, K, ld; const bf16_t* A2 = nullptr; const bf16_t* Bt2 = nullptr; int nsplit = 1 << 30; };
struct StaticOrder {
  int nM, nN, nwg, G, c, nNr;
  __device__ void init(int M, int N, int G_, int c_, int ksplit = 1) { nM = M / BM; nNr = N / BM; nN = nNr * ksplit; nwg = nM * nN; G = G_; c = c_; }
  __device__ bool next(int i, Unit& u) const {
    const long L = (long)i * G + c; if (L >= nwg) return false;
    int wgid = (int)L; { const int q = nwg / NXCD, r = nwg % NXCD, xcd = wgid % NXCD, off = wgid / NXCD; wgid = (xcd < r ? xcd * (q + 1) : r * (q + 1) + (xcd - r) * q) + off; }
    const int nig = WGM * nN, gid = wgid / nig, fm = gid * WGM, gsz = (nM - fm) < WGM ? (nM - fm) : WGM;
    u.pm = fm + ((wgid % nig) % gsz); const int pv = (wgid % nig) / gsz; u.pn = pv % nNr; u.ks = pv / nNr; return true;
  }
};
template <class Epi>
__device__ __forceinline__ void gemm_phase(LAS unsigned char* lds, const Gemm g, const StaticOrder& S, const Epi& E) {
  const int tid = opaque_tid(), wid = __builtin_amdgcn_readfirstlane(tid >> 6), lane = tid & 63, wr = wid >> 2, wc = wid & 3, fr = lane & 15, fq = lane >> 4;
  const int K = g.K, nt = K / BK, LD = g.ld;
  unsigned voffA[2], voffB[2];
#pragma unroll
  for (int i = 0; i < 2; ++i) { int R, C; stage_rc(tid * 16 + i * 8192, R, C); const int Rb = Epi::PERM ? ((R & ~31) + perm32(R & 31)) : R;
    voffA[i] = (unsigned)(R * LD + C) * 2u; voffB[i] = (unsigned)(Rb * LD + C) * 2u; }
  const size_t kstep = (size_t)(BK * 2);
  const size_t hstep = (size_t)HALF * LD * 2;
  const size_t ksb = (size_t)K * 2;
  const size_t tstep = 2 * hstep;
  const unsigned ldsw = (unsigned)wid * 1024u;
  const int aoff = lds_byte(wr * 64 + fr, fq * 8), boff = lds_byte(wc * 32 + fr, fq * 8);
#define PG8_SA(b, h) (((b) * 2 + (h)) * HTB)
#define PG8_SB(b, h) ((4 + (b) * 2 + (h)) * HTB)
#define PG8_STAGE(bufoff, gbase, voff) do { _Pragma("unroll") for (int _i = 0; _i < 2; ++_i) \
    __builtin_amdgcn_global_load_lds((const unsigned*)((const char*)(gbase) + (voff)[_i]), (LAS unsigned*)(lds + (bufoff) + ldsw + _i * 8192), 16, 0, 0); } while (0)
#define PG8_LDA(dst, b, h) do { _Pragma("unroll") for (int m = 0; m < 4; ++m) _Pragma("unroll") for (int k = 0; k < 2; ++k) dst[m][k] = *(const LAS bf16x8*)(lds + PG8_SA(b, h) + aoff + m * 2048 + k * 1024); } while (0)
#define PG8_LDB(dst, b, h) do { _Pragma("unroll") for (int n = 0; n < 2; ++n) _Pragma("unroll") for (int k = 0; k < 2; ++k) dst[n][k] = *(const LAS bf16x8*)(lds + PG8_SB(b, h) + boff + n * 2048 + k * 1024); } while (0)
#define PG8_MMA(ai, bj, At, Bt) do { __builtin_amdgcn_s_setprio(1); _Pragma("unroll") for (int m = 0; m < 4; ++m) _Pragma("unroll") for (int n = 0; n < 2; ++n) _Pragma("unroll") for (int k = 0; k < 2; ++k) \
    acc[ai][bj][m][n] = __builtin_amdgcn_mfma_f32_16x16x32_bf16(Bt[n][k], At[m][k], acc[ai][bj][m][n], 0, 0, 0); __builtin_amdgcn_s_setprio(0); } while (0)
#define PG8_WAIT_V(n) asm volatile("s_waitcnt vmcnt(" #n ")" ::: "memory")
#define PG8_WAIT_L(n) asm volatile("s_waitcnt lgkmcnt(" #n ")" ::: "memory")
#define PG8_BAR __builtin_amdgcn_s_barrier()
#define PG8_SCHED __builtin_amdgcn_sched_barrier(0)
  Unit cur, nxt; int ui = 0;
  if (!S.next(0, cur)) return;
  f32x4 acc[2][2][4][2];
#pragma unroll
  for (int a = 0; a < 2; ++a)
#pragma unroll
    for (int b = 0; b < 2; ++b)
#pragma unroll
      for (int m = 0; m < 4; ++m)
#pragma unroll
        for (int n = 0; n < 2; ++n) acc[a][b][m][n] = (f32x4){0.f, 0.f, 0.f, 0.f};
  bf16x8 At[4][2], B0[2][2], B1[2][2];
  const long dA2 = g.A2 ? (long)((const char*)g.A2 - (const char*)g.A) : 0L;
  const long dB2 = g.Bt2 ? (long)((const char*)g.Bt2 - (const char*)g.Bt) - (long)g.nsplit * (long)tstep : 0L;
#define PG8_UA(u_) ((const char*)g.A + (size_t)(u_).pm * tstep + (size_t)(u_).ks * ksb + ((u_).pn >= g.nsplit ? dA2 : 0L))
#define PG8_UB(u_) ((const char*)g.Bt + (size_t)(u_).pn * tstep + (size_t)(u_).ks * ksb + ((u_).pn >= g.nsplit ? dB2 : 0L))
  const char* cA = PG8_UA(cur); const char* cB = PG8_UB(cur);
  PG8_STAGE(PG8_SB(0, 0), cB, voffB); PG8_STAGE(PG8_SA(0, 0), cA, voffA); PG8_STAGE(PG8_SB(0, 1), cB + hstep, voffB); PG8_STAGE(PG8_SA(0, 1), cA + hstep, voffA);
  if (wr == 1) PG8_BAR;
  PG8_WAIT_V(4); PG8_BAR;
  PG8_STAGE(PG8_SB(1, 0), cB + kstep, voffB); PG8_STAGE(PG8_SA(1, 0), cA + kstep, voffA); PG8_STAGE(PG8_SB(1, 1), cB + hstep + kstep, voffB);
  PG8_WAIT_V(6); PG8_BAR;
  for (;;) {
    const bool has_next = S.next(ui + 1, nxt);
    const char* nA = has_next ? PG8_UA(nxt) : cA; const char* nB = has_next ? PG8_UB(nxt) : cB;
    for (int t = 0; t < nt; t += 2) {
      const bool last = (t == nt - 2);
      const char* a1 = cA + (size_t)(t + 1) * kstep;
      const char* a2 = last ? nA : cA + (size_t)(t + 2) * kstep; const char* b2 = last ? nB : cB + (size_t)(t + 2) * kstep;
      const char* a3 = a2 + kstep; const char* b3 = b2 + kstep;
      PG8_LDB(B0, 0, 0); PG8_SCHED; PG8_LDA(At, 0, 0); PG8_STAGE(PG8_SA(1, 1), a1 + hstep, voffA);
      PG8_WAIT_L(8); PG8_BAR; PG8_WAIT_L(0); PG8_MMA(0, 0, At, B0); PG8_BAR; PG8_SCHED;
      PG8_LDB(B1, 0, 1); PG8_STAGE(PG8_SB(0, 0), b2, voffB);
      PG8_BAR; PG8_WAIT_L(0); PG8_MMA(0, 1, At, B1); PG8_BAR;
      PG8_LDA(At, 0, 1); PG8_STAGE(PG8_SA(0, 0), a2, voffA);
      PG8_BAR; PG8_WAIT_L(0); PG8_MMA(1, 0, At, B0); PG8_BAR; PG8_SCHED;
      PG8_STAGE(PG8_SB(0, 1), b2 + hstep, voffB);
      PG8_WAIT_V(6); PG8_BAR; PG8_MMA(1, 1, At, B1); PG8_BAR;
      PG8_LDB(B0, 1, 0); PG8_SCHED; PG8_LDA(At, 1, 0); PG8_STAGE(PG8_SA(0, 1), a2 + hstep, voffA);
      PG8_WAIT_L(8); PG8_BAR; PG8_WAIT_L(0); PG8_MMA(0, 0, At, B0); PG8_BAR; PG8_SCHED;
      PG8_LDB(B1, 1, 1); PG8_STAGE(PG8_SB(1, 0), b3, voffB);
      PG8_BAR; PG8_WAIT_L(0); PG8_MMA(0, 1, At, B1); PG8_BAR;
      PG8_LDA(At, 1, 1); PG8_STAGE(PG8_SA(1, 0), a3, voffA);
      PG8_BAR; PG8_WAIT_L(0); PG8_MMA(1, 0, At, B0); PG8_BAR; PG8_SCHED;
      PG8_STAGE(PG8_SB(1, 1), b3 + hstep, voffB);
      PG8_WAIT_V(6); PG8_BAR; PG8_MMA(1, 1, At, B1); PG8_BAR;
    }
    E(acc, cur, wr, wc, fr, fq);
    if (!has_next) break;
#pragma unroll
    for (int a = 0; a < 2; ++a)
#pragma unroll
      for (int b = 0; b < 2; ++b)
#pragma unroll
        for (int m = 0; m < 4; ++m)
#pragma unroll
          for (int n = 0; n < 2; ++n) acc[a][b][m][n] = (f32x4){0.f, 0.f, 0.f, 0.f};
    cur = nxt; cA = nA; cB = nB; ++ui;
  }
  PG8_WAIT_V(0);
  if (wr == 0) PG8_BAR;
  PG8_BAR;
#undef PG8_UA
#undef PG8_UB
#undef PG8_SA
#undef PG8_SB
#undef PG8_STAGE
#undef PG8_LDA
#undef PG8_LDB
#undef PG8_MMA
#undef PG8_WAIT_V
#undef PG8_WAIT_L
#undef PG8_BAR
#undef PG8_SCHED
}
}
using pg8::Unit;
typedef f32x4 AccT[2][2][4][2];

struct EpiIn {
  static constexpr bool PERM = true;
  bf16_t *R, *K, *V, *CB, *U, *LOR;
  __device__ __forceinline__ void operator()(const AccT& acc, const Unit& u, int wr, int wc, int fr, int fq) const {
    const int row0 = u.pm * 256 + wr * 64 + fr;
    const __amdgpu_buffer_rsrc_t rs = wt_rsrc(R);
    if (u.pn < 16) {
      bf16_t* base = (u.pn < 4) ? R : (u.pn < 8) ? K : (u.pn < 12) ? V : CB;
      const int col0 = (u.pn & 3) * 256 + wc * 32 + 8 * fq;
#pragma unroll
      for (int ai = 0; ai < 2; ++ai)
#pragma unroll
        for (int m = 0; m < 4; ++m) { bf16_t* rowp = base + (size_t)(row0 + ai * 128 + m * 16) * DM + col0;
#pragma unroll
          for (int bj = 0; bj < 2; ++bj) { const f32x4 v0 = acc[ai][bj][m][0], v1 = acc[ai][bj][m][1];
            u32x4 o; o[0] = cvt_pk_bf16(v0[0], v0[1]); o[1] = cvt_pk_bf16(v0[2], v0[3]); o[2] = cvt_pk_bf16(v1[0], v1[1]); o[3] = cvt_pk_bf16(v1[2], v1[3]);
            st16_wt(rs, R, rowp + bj * 128, o); } }
    } else if (u.pn < 24) {
      const int ch0 = (u.pn - 16) * 128 + wc * 32 + 8 * fq;
#pragma unroll
      for (int ai = 0; ai < 2; ++ai)
#pragma unroll
        for (int m = 0; m < 4; ++m) { bf16_t* rowp = U + (size_t)(row0 + ai * 128 + m * 16) * DM + ch0;
          const f32x4 p0 = acc[ai][0][m][0] * acc[ai][0][m][1], p1 = acc[ai][1][m][0] * acc[ai][1][m][1];
          u32x4 o; o[0] = cvt_pk_bf16(p0[0], p0[1]); o[1] = cvt_pk_bf16(p0[2], p0[3]); o[2] = cvt_pk_bf16(p1[0], p1[1]); o[3] = cvt_pk_bf16(p1[2], p1[3]);
          st16_wt(rs, R, rowp, o); }
    } else {
      const int colw = wc * 32 + 8 * fq;
#pragma unroll
      for (int ai = 0; ai < 2; ++ai)
#pragma unroll
        for (int m = 0; m < 4; ++m) { bf16_t* rowp = LOR + (size_t)(row0 + ai * 128 + m * 16) * 384;
#pragma unroll
          for (int bj = 0; bj < 2; ++bj) {
            f32x4 v0 = acc[ai][bj][m][0], v1 = acc[ai][bj][m][1];
            if (u.pn == 24) {
              if (bj == 0) {
#pragma unroll
                for (int j = 0; j < 4; ++j) { v0[j] = 1.0f - 2.0f * __builtin_amdgcn_rcpf(1.0f + __expf(2.0f * v0[j])); v1[j] = 1.0f - 2.0f * __builtin_amdgcn_rcpf(1.0f + __expf(2.0f * v1[j])); }
              }
              u32x4 o; o[0] = cvt_pk_bf16(v0[0], v0[1]); o[1] = cvt_pk_bf16(v0[2], v0[3]); o[2] = cvt_pk_bf16(v1[0], v1[1]); o[3] = cvt_pk_bf16(v1[2], v1[3]);
              *(u32x4*)(rowp + bj * 128 + colw) = o;
            } else if (bj == 0) {
#pragma unroll
              for (int j = 0; j < 4; ++j) { v0[j] = sigmoidf_(v0[j]); v1[j] = sigmoidf_(v1[j]); }
              u32x4 o; o[0] = cvt_pk_bf16(v0[0], v0[1]); o[1] = cvt_pk_bf16(v0[2], v0[3]); o[2] = cvt_pk_bf16(v1[0], v1[1]); o[3] = cvt_pk_bf16(v1[2], v1[3]);
              *(u32x4*)(rowp + 256 + colw) = o;
            }
          } }
    }
  }
};
struct EpiGate {
  static constexpr bool PERM = true;
  bf16_t *GA, *GB, *YR;
  __device__ __forceinline__ void operator()(const AccT& acc, const Unit& u, int wr, int wc, int fr, int fq) const {
    const int row0 = u.pm * 256 + wr * 64 + fr;
    long boff = 0L; if (u.pn >= 4) boff = (long)((char*)GB - (char*)GA); if (u.pn >= 8) boff = (long)((char*)YR - (char*)GA);
    bf16_t* base = (bf16_t*)((char*)GA + boff);
    const bool sg = u.pn < 8;
    const int col0 = (u.pn & 3) * 256 + wc * 32 + 8 * fq;
#pragma unroll
    for (int ai = 0; ai < 2; ++ai)
#pragma unroll
      for (int m = 0; m < 4; ++m) { bf16_t* rowp = base + (size_t)(row0 + ai * 128 + m * 16) * DM + col0;
#pragma unroll
        for (int bj = 0; bj < 2; ++bj) { f32x4 v0 = acc[ai][bj][m][0], v1 = acc[ai][bj][m][1];
          if (sg) {
#pragma unroll
            for (int j = 0; j < 4; ++j) { v0[j] = sigmoidf_(v0[j]); v1[j] = sigmoidf_(v1[j]); } }
          u32x4 o; o[0] = cvt_pk_bf16(v0[0], v0[1]); o[1] = cvt_pk_bf16(v0[2], v0[3]); o[2] = cvt_pk_bf16(v1[0], v1[1]); o[3] = cvt_pk_bf16(v1[2], v1[3]);
          *(u32x4*)(rowp + bj * 128) = o; } }
  }
};
struct EpiYa {
  static constexpr bool PERM = true;
  const bf16_t* GA; const bf16_t* GB; bf16_t* O;
  __device__ __forceinline__ void operator()(const AccT& acc, const Unit& u, int wr, int wc, int fr, int fq) const {
    const int row0 = u.pm * 256 + wr * 64 + fr; const int col0 = u.pn * 256 + wc * 32 + 8 * fq;
#pragma unroll
    for (int ai = 0; ai < 2; ++ai)
#pragma unroll
      for (int m = 0; m < 4; ++m) { const size_t off = (size_t)(row0 + ai * 128 + m * 16) * DM + col0;
#pragma unroll
        for (int bj = 0; bj < 2; ++bj) { const f32x4 v0 = acc[ai][bj][m][0], v1 = acc[ai][bj][m][1];
          const u32x4 ga = *(const u32x4*)(GA + off + bj * 128), gb = *(const u32x4*)(GB + off + bj * 128), yr = *(const u32x4*)(O + off + bj * 128);
          float r[8];
          r[0] = lo_bf(ga[0]) * v0[0] + lo_bf(gb[0]) * lo_bf(yr[0]); r[1] = hi_bf(ga[0]) * v0[1] + hi_bf(gb[0]) * hi_bf(yr[0]);
          r[2] = lo_bf(ga[1]) * v0[2] + lo_bf(gb[1]) * lo_bf(yr[1]); r[3] = hi_bf(ga[1]) * v0[3] + hi_bf(gb[1]) * hi_bf(yr[1]);
          r[4] = lo_bf(ga[2]) * v1[0] + lo_bf(gb[2]) * lo_bf(yr[2]); r[5] = hi_bf(ga[2]) * v1[1] + hi_bf(gb[2]) * hi_bf(yr[2]);
          r[6] = lo_bf(ga[3]) * v1[2] + lo_bf(gb[3]) * lo_bf(yr[3]); r[7] = hi_bf(ga[3]) * v1[3] + hi_bf(gb[3]) * hi_bf(yr[3]);
          u32x4 o; o[0] = cvt_pk_bf16(r[0], r[1]); o[1] = cvt_pk_bf16(r[2], r[3]); o[2] = cvt_pk_bf16(r[4], r[5]); o[3] = cvt_pk_bf16(r[6], r[7]);
          *(u32x4*)(O + off + bj * 128) = o; } }
  }
};
template <bool ADD> struct EpiY {
  static constexpr bool PERM = true;
  const bf16_t* G; bf16_t* O;
  __device__ __forceinline__ void operator()(const AccT& acc, const Unit& u, int wr, int wc, int fr, int fq) const {
    const int row0 = u.pm * 256 + wr * 64 + fr; const int col0 = u.pn * 256 + wc * 32 + 8 * fq;
#pragma unroll
    for (int ai = 0; ai < 2; ++ai)
#pragma unroll
      for (int m = 0; m < 4; ++m) { const size_t off = (size_t)(row0 + ai * 128 + m * 16) * DM + col0;
#pragma unroll
        for (int bj = 0; bj < 2; ++bj) { const f32x4 v0 = acc[ai][bj][m][0], v1 = acc[ai][bj][m][1];
          const u32x4 g = *(const u32x4*)(G + off + bj * 128);
          float r[8];
          r[0] = lo_bf(g[0]) * v0[0]; r[1] = hi_bf(g[0]) * v0[1]; r[2] = lo_bf(g[1]) * v0[2]; r[3] = hi_bf(g[1]) * v0[3];
          r[4] = lo_bf(g[2]) * v1[0]; r[5] = hi_bf(g[2]) * v1[1]; r[6] = lo_bf(g[3]) * v1[2]; r[7] = hi_bf(g[3]) * v1[3];
          if (ADD) { const u32x4 p = *(const u32x4*)(O + off + bj * 128);
            r[0] += lo_bf(p[0]); r[1] += hi_bf(p[0]); r[2] += lo_bf(p[1]); r[3] += hi_bf(p[1]);
            r[4] += lo_bf(p[2]); r[5] += hi_bf(p[2]); r[6] += lo_bf(p[3]); r[7] += hi_bf(p[3]); }
          u32x4 o; o[0] = cvt_pk_bf16(r[0], r[1]); o[1] = cvt_pk_bf16(r[2], r[3]); o[2] = cvt_pk_bf16(r[4], r[5]); o[3] = cvt_pk_bf16(r[6], r[7]);
          *(u32x4*)(O + off + bj * 128) = o; } }
  }
};
struct EpiRes {
  static constexpr bool PERM = false;
  const float* x0; const float* x1; float* OUT; const float* gate;
  __device__ __forceinline__ void operator()(const AccT& acc, const Unit& u, int wr, int wc, int fr, int fq) const {
    const int rowt = u.pm * 256; const int mi = mod_index(rowt);
    const int row0 = rowt + wr * 64 + fr, col0 = u.pn * 256 + wc * 32 + 4 * fq;
    const float* gp = gate + (size_t)mi * 6144 + col0;
    f32x4 gv[2][2];
#pragma unroll
    for (int bj = 0; bj < 2; ++bj)
#pragma unroll
      for (int n = 0; n < 2; ++n) gv[bj][n] = *(const f32x4*)(gp + bj * 128 + n * 16);
#pragma unroll
    for (int ai = 0; ai < 2; ++ai)
#pragma unroll
      for (int m = 0; m < 4; ++m) { const int row = row0 + ai * 128 + m * 16;
        const float* xr = x0 ? ((row < NCTX) ? x0 + (size_t)row * DM : x1 + (size_t)(row - NCTX) * DM) : OUT + (size_t)row * DM;
        float* orow = OUT + (size_t)row * DM;
#pragma unroll
        for (int bj = 0; bj < 2; ++bj)
#pragma unroll
          for (int n = 0; n < 2; ++n) { const int c = col0 + bj * 128 + n * 16;
            const f32x4 xv = *(const f32x4*)(xr + c);
            *(f32x4*)(orow + c) = xv + gv[bj][n] * acc[ai][bj][m][n]; } }
  }
};
template <bool FROMX> struct EpiResB {
  static constexpr bool PERM = true;
  const float* x0; const float* x1; const bf16_t* XI; bf16_t* XO; const float* gate; int row_base;
  __device__ __forceinline__ void operator()(const AccT& acc, const Unit& u, int wr, int wc, int fr, int fq) const {
    const int rowt = row_base + u.pm * 256; const int mi = mod_index(rowt);
    const int row0 = rowt + wr * 64 + fr, col0 = u.pn * 256 + wc * 32 + 8 * fq;
    const float* gp = gate + (size_t)mi * 6144 + col0;
    f32x4 gv[2][2];
#pragma unroll
    for (int bj = 0; bj < 2; ++bj)
#pragma unroll
      for (int n = 0; n < 2; ++n) gv[bj][n] = *(const f32x4*)(gp + bj * 128 + 4 * n);
#pragma unroll
    for (int ai = 0; ai < 2; ++ai)
#pragma unroll
      for (int m = 0; m < 4; ++m) { const int row = row0 + ai * 128 + m * 16;
        const float* xr = FROMX ? ((row < NCTX) ? x0 + (size_t)row * DM : x1 + (size_t)(row - NCTX) * DM) : nullptr;
#pragma unroll
        for (int bj = 0; bj < 2; ++bj) { const int c = col0 + bj * 128;
          f32x4 xa, xb;
          if (FROMX) { xa = *(const f32x4*)(xr + c); xb = *(const f32x4*)(xr + c + 4); }
          else { const u32x4 pv = *(const u32x4*)(XI + (size_t)row * DM + c); xa = (f32x4){lo_bf(pv[0]), hi_bf(pv[0]), lo_bf(pv[1]), hi_bf(pv[1])}; xb = (f32x4){lo_bf(pv[2]), hi_bf(pv[2]), lo_bf(pv[3]), hi_bf(pv[3])}; }
          const f32x4 oa = xa + gv[bj][0] * acc[ai][bj][m][0], ob = xb + gv[bj][1] * acc[ai][bj][m][1];
          u32x4 o; o[0] = cvt_pk_bf16(oa[0], oa[1]); o[1] = cvt_pk_bf16(oa[2], oa[3]); o[2] = cvt_pk_bf16(ob[0], ob[1]); o[3] = cvt_pk_bf16(ob[2], ob[3]);
          *(u32x4*)(XO + (size_t)row * DM + c) = o; } }
  }
};
struct EpiFf2Split {
  static constexpr bool PERM = true;
  const bf16_t* XI; bf16_t* XO; const float* gate; bf16_t* PART; int row_base;
  __device__ __forceinline__ void operator()(const AccT& acc, const Unit& u, int wr, int wc, int fr, int fq) const {
    const int rowl0 = u.pm * 256 + wr * 64 + fr, col0 = u.pn * 256 + wc * 32 + 8 * fq;
    if (u.ks == 0) {
      const float* gp = gate + (size_t)mod_index(row_base + u.pm * 256) * 6144 + col0;
      f32x4 gv[2][2];
#pragma unroll
      for (int bj = 0; bj < 2; ++bj)
#pragma unroll
        for (int n = 0; n < 2; ++n) gv[bj][n] = *(const f32x4*)(gp + bj * 128 + 4 * n);
#pragma unroll
      for (int ai = 0; ai < 2; ++ai)
#pragma unroll
        for (int m = 0; m < 4; ++m) { const size_t ro = (size_t)(row_base + rowl0 + ai * 128 + m * 16) * DM;
#pragma unroll
          for (int bj = 0; bj < 2; ++bj) { const int c = col0 + bj * 128; const u32x4 pv = *(const u32x4*)(XI + ro + c);
            const f32x4 xa = {lo_bf(pv[0]), hi_bf(pv[0]), lo_bf(pv[1]), hi_bf(pv[1])}, xb = {lo_bf(pv[2]), hi_bf(pv[2]), lo_bf(pv[3]), hi_bf(pv[3])};
            const f32x4 oa = xa + gv[bj][0] * acc[ai][bj][m][0], ob = xb + gv[bj][1] * acc[ai][bj][m][1];
            u32x4 o; o[0] = cvt_pk_bf16(oa[0], oa[1]); o[1] = cvt_pk_bf16(oa[2], oa[3]); o[2] = cvt_pk_bf16(ob[0], ob[1]); o[3] = cvt_pk_bf16(ob[2], ob[3]);
            *(u32x4*)(XO + ro + c) = o; } }
    } else {
#pragma unroll
      for (int ai = 0; ai < 2; ++ai)
#pragma unroll
        for (int m = 0; m < 4; ++m) { bf16_t* prow = PART + (size_t)(rowl0 + ai * 128 + m * 16) * DM;
#pragma unroll
          for (int bj = 0; bj < 2; ++bj) { const f32x4 v0 = acc[ai][bj][m][0], v1 = acc[ai][bj][m][1];
            u32x4 o; o[0] = cvt_pk_bf16(v0[0], v0[1]); o[1] = cvt_pk_bf16(v0[2], v0[3]); o[2] = cvt_pk_bf16(v1[0], v1[1]); o[3] = cvt_pk_bf16(v1[2], v1[3]);
            *(u32x4*)(prow + col0 + bj * 128) = o; } }
    }
  }
};
struct EpiFf1 {
  static constexpr bool PERM = true;
  bf16_t* H;
  __device__ __forceinline__ void operator()(const AccT& acc, const Unit& u, int wr, int wc, int fr, int fq) const {
    const int row0 = u.pm * 256 + wr * 64 + fr; const int col0 = u.pn * 256 + wc * 32 + 8 * fq;
    const __amdgpu_buffer_rsrc_t rs = wt_rsrc(H);
#pragma unroll
    for (int ai = 0; ai < 2; ++ai)
#pragma unroll
      for (int m = 0; m < 4; ++m) { bf16_t* rowp = H + (size_t)(row0 + ai * 128 + m * 16) * 4096 + col0;
#pragma unroll
        for (int bj = 0; bj < 2; ++bj) { f32x4 v0 = acc[ai][bj][m][0], v1 = acc[ai][bj][m][1];
#pragma unroll
          for (int j = 0; j < 4; ++j) { const float a = fmaxf(v0[j], 0.f), b = fmaxf(v1[j], 0.f); v0[j] = a * a; v1[j] = b * b; }
          u32x4 o; o[0] = cvt_pk_bf16(v0[0], v0[1]); o[1] = cvt_pk_bf16(v0[2], v0[3]); o[2] = cvt_pk_bf16(v1[0], v1[1]); o[3] = cvt_pk_bf16(v1[2], v1[3]);
          st16_wt(rs, H, rowp + bj * 128, o); } }
  }
};

__device__ __forceinline__ int win_col(int o) {
  if (o < 3072) return o;
  if (o < 4096) return 3456 + (o - 3072);
  if (o < 6144) { const int t = (o - 4096) >> 8, l = (o - 4096) & 255;
    const int bj = l >> 7, wc = (l >> 5) & 3, fq = (l >> 3) & 3, n = (l >> 2) & 1, j = l & 3;
    return (n ? 5504 : 4480) + t * 128 + wc * 32 + fq * 8 + bj * 4 + j; }
  if (o < 6656) { const int l = o - 6144; return l < 384 ? 3072 + l : -1; }
  return 6528 + (o - 6656);
}
template <bool WIN>
__device__ void transpose_job(LAS float* tile, const float* src, int srcN, bf16_t* dst, int O, int K) {
  const int tid = opaque_tid(), nkt = K / 64, ntiles = (O / 64) * nkt;
  for (int tI = blockIdx.x; tI < ntiles; tI += gridDim.x) {
    const int o0 = (tI / nkt) * 64, k0 = (tI % nkt) * 64;
    { const int tx = (tid & 15) * 4, ty = tid >> 4; const int o = o0 + tx; const int c = WIN ? win_col(o) : o;
#pragma unroll
      for (int i = 0; i < 2; ++i) { const int kl = ty + 32 * i; const f32x4 v = (c >= 0) ? *(const f32x4*)(src + (size_t)(k0 + kl) * srcN + c) : (f32x4){0.f, 0.f, 0.f, 0.f};
        tile[kl * 65 + tx] = v[0]; tile[kl * 65 + tx + 1] = v[1]; tile[kl * 65 + tx + 2] = v[2]; tile[kl * 65 + tx + 3] = v[3]; } }
    __syncthreads();
    { const int oy = tid >> 3, kx = (tid & 7) * 8; float v[8];
#pragma unroll
      for (int i = 0; i < 8; ++i) v[i] = tile[(kx + i) * 65 + oy];
      u32x4 o; o[0] = cvt_pk_bf16(v[0], v[1]); o[1] = cvt_pk_bf16(v[2], v[3]); o[2] = cvt_pk_bf16(v[4], v[5]); o[3] = cvt_pk_bf16(v[6], v[7]);
      *(u32x4*)(dst + (size_t)(o0 + oy) * K + k0 + kx) = o; }
    __syncthreads();
  }
}

template <int MODE, bool SRC16 = false>
__device__ void norm_rows(const float* x0, const float* x1, const float* g, const float* mod, int sh_off, int sc_off, bf16_t* dst, float* fout, const bf16_t* src16 = nullptr) {
  const int tid_ = opaque_tid(); const int lane = tid_ & 63, gw = blockIdx.x * 8 + (tid_ >> 6), nw = gridDim.x * 8;
  f32x4 gv[4];
#pragma unroll
  for (int i = 0; i < 4; ++i) gv[i] = *(const f32x4*)(g + i * 256 + lane * 4);
  const int rpw = (NT + gridDim.x - 1) / gridDim.x, rpv = (rpw + 7) / 8;
  const int rbeg = blockIdx.x * rpw + (tid_ >> 6) * rpv, rend = min(min(rbeg + rpv, (int)(blockIdx.x + 1) * rpw), NT);
  int cmi = -1; f32x4 scv[4], shv[4];
#pragma unroll
  for (int i = 0; i < 4; ++i) { scv[i] = (f32x4){0.f, 0.f, 0.f, 0.f}; shv[i] = (f32x4){0.f, 0.f, 0.f, 0.f}; }
  for (int row = rbeg; row < rend; row += 2) {
    const int rowb = (row + 1 < rend) ? (row + 1) : row;
    const float* xa = (row < NCTX) ? x0 + (size_t)row * DM : x1 + (size_t)(row - NCTX) * DM;
    const float* xb = (rowb < NCTX) ? x0 + (size_t)rowb * DM : x1 + (size_t)(rowb - NCTX) * DM;
    f32x4 va[4], vb[4]; float sa = 0.f, sb = 0.f;
    if (SRC16) {
#pragma unroll
      for (int i = 0; i < 4; ++i) { const u32x2 pa = *(const u32x2*)(src16 + (size_t)row * DM + i * 256 + lane * 4), pb = *(const u32x2*)(src16 + (size_t)rowb * DM + i * 256 + lane * 4);
        va[i] = (f32x4){lo_bf(pa[0]), hi_bf(pa[0]), lo_bf(pa[1]), hi_bf(pa[1])}; vb[i] = (f32x4){lo_bf(pb[0]), hi_bf(pb[0]), lo_bf(pb[1]), hi_bf(pb[1])}; }
    } else {
#pragma unroll
      for (int i = 0; i < 4; ++i) { va[i] = *(const f32x4*)(xa + i * 256 + lane * 4); vb[i] = *(const f32x4*)(xb + i * 256 + lane * 4); }
    }
    if (MODE == 1) {
      if (row >= 16384) { const float* gp = mod + (size_t)mod_index(row) * 6144 + sh_off; const bf16_t* pp = dst + (size_t)(row - 16384) * DM;
#pragma unroll
        for (int i = 0; i < 4; ++i) { const int cc = i * 256 + lane * 4; const u32x2 pv = *(const u32x2*)(pp + cc); const f32x4 gt = *(const f32x4*)(gp + cc);
          va[i][0] += gt[0] * lo_bf(pv[0]); va[i][1] += gt[1] * hi_bf(pv[0]); va[i][2] += gt[2] * lo_bf(pv[1]); va[i][3] += gt[3] * hi_bf(pv[1]); } }
      if (rowb >= 16384) { const float* gp = mod + (size_t)mod_index(rowb) * 6144 + sh_off; const bf16_t* pp = dst + (size_t)(rowb - 16384) * DM;
#pragma unroll
        for (int i = 0; i < 4; ++i) { const int cc = i * 256 + lane * 4; const u32x2 pv = *(const u32x2*)(pp + cc); const f32x4 gt = *(const f32x4*)(gp + cc);
          vb[i][0] += gt[0] * lo_bf(pv[0]); vb[i][1] += gt[1] * hi_bf(pv[0]); vb[i][2] += gt[2] * lo_bf(pv[1]); vb[i][3] += gt[3] * hi_bf(pv[1]); } }
    }
#pragma unroll
    for (int i = 0; i < 4; ++i) { sa += va[i][0] * va[i][0] + va[i][1] * va[i][1] + va[i][2] * va[i][2] + va[i][3] * va[i][3];
                                  sb += vb[i][0] * vb[i][0] + vb[i][1] * vb[i][1] + vb[i][2] * vb[i][2] + vb[i][3] * vb[i][3]; }
    sa = wave_sum(sa); sb = wave_sum(sb);
    const float ra = rsqrtf(sa * (1.0f / 1024.0f) + 1e-6f), rb = rsqrtf(sb * (1.0f / 1024.0f) + 1e-6f);
    if (MODE == 0) {
      const int mia = mod_index(row), mib = mod_index(rowb);
      if (mia != cmi) { cmi = mia; const float* ma = mod + (size_t)mia * 6144;
#pragma unroll
        for (int i = 0; i < 4; ++i) { scv[i] = *(const f32x4*)(ma + sc_off + i * 256 + lane * 4) + 1.0f; shv[i] = *(const f32x4*)(ma + sh_off + i * 256 + lane * 4); } }
      f32x4 scb[4], shb[4];
#pragma unroll
      for (int i = 0; i < 4; ++i) { scb[i] = scv[i]; shb[i] = shv[i]; }
      if (mib != mia) { const float* mb = mod + (size_t)mib * 6144;
#pragma unroll
        for (int i = 0; i < 4; ++i) { scb[i] = *(const f32x4*)(mb + sc_off + i * 256 + lane * 4) + 1.0f; shb[i] = *(const f32x4*)(mb + sh_off + i * 256 + lane * 4); } }
#pragma unroll
      for (int i = 0; i < 4; ++i) { const int cc = i * 256 + lane * 4;
        const f32x4 oa = va[i] * ra * gv[i] * scv[i] + shv[i], ob = vb[i] * rb * gv[i] * scb[i] + shb[i];
        u32x2 pa, pb; pa[0] = cvt_pk_bf16(oa[0], oa[1]); pa[1] = cvt_pk_bf16(oa[2], oa[3]); pb[0] = cvt_pk_bf16(ob[0], ob[1]); pb[1] = cvt_pk_bf16(ob[2], ob[3]);
        *(u32x2*)(dst + (size_t)row * DM + cc) = pa; if (rowb != row) *(u32x2*)(dst + (size_t)rowb * DM + cc) = pb; }
    } else {
#pragma unroll
      for (int i = 0; i < 4; ++i) { const int cc = i * 256 + lane * 4;
        *(f32x4*)(fout + (size_t)row * DM + cc) = va[i] * ra * gv[i]; if (rowb != row) *(f32x4*)(fout + (size_t)rowb * DM + cc) = vb[i] * rb * gv[i]; }
    }
  }
}

__device__ void norm_rows_b16(const bf16_t* src16, const float* g, const float* mod, int sh_off, int sc_off, bf16_t* dst) {
  const int tid_ = opaque_tid(); const int lane = tid_ & 63;
  f32x4 gv[4];
#pragma unroll
  for (int i = 0; i < 4; ++i) gv[i] = *(const f32x4*)(g + (i >> 1) * 512 + lane * 8 + (i & 1) * 4);
  const int rpw = (NT + gridDim.x - 1) / gridDim.x, rpv = (rpw + 7) / 8;
  const int rbeg = blockIdx.x * rpw + (tid_ >> 6) * rpv, rend = min(min(rbeg + rpv, (int)(blockIdx.x + 1) * rpw), NT);
  int cmi = -1; f32x4 scv[4], shv[4];
#pragma unroll
  for (int i = 0; i < 4; ++i) { scv[i] = (f32x4){0.f, 0.f, 0.f, 0.f}; shv[i] = (f32x4){0.f, 0.f, 0.f, 0.f}; }
  for (int row = rbeg; row < rend; row += 2) {
    const int rowb = (row + 1 < rend) ? (row + 1) : row;
    f32x4 va[4], vb[4]; float sa = 0.f, sb = 0.f;
#pragma unroll
    for (int h2 = 0; h2 < 2; ++h2) { const u32x4 pa = *(const u32x4*)(src16 + (size_t)row * DM + h2 * 512 + lane * 8), pb = *(const u32x4*)(src16 + (size_t)rowb * DM + h2 * 512 + lane * 8);
      va[2 * h2] = (f32x4){lo_bf(pa[0]), hi_bf(pa[0]), lo_bf(pa[1]), hi_bf(pa[1])}; va[2 * h2 + 1] = (f32x4){lo_bf(pa[2]), hi_bf(pa[2]), lo_bf(pa[3]), hi_bf(pa[3])};
      vb[2 * h2] = (f32x4){lo_bf(pb[0]), hi_bf(pb[0]), lo_bf(pb[1]), hi_bf(pb[1])}; vb[2 * h2 + 1] = (f32x4){lo_bf(pb[2]), hi_bf(pb[2]), lo_bf(pb[3]), hi_bf(pb[3])}; }
#pragma unroll
    for (int i = 0; i < 4; ++i) { sa += va[i][0] * va[i][0] + va[i][1] * va[i][1] + va[i][2] * va[i][2] + va[i][3] * va[i][3];
                                  sb += vb[i][0] * vb[i][0] + vb[i][1] * vb[i][1] + vb[i][2] * vb[i][2] + vb[i][3] * vb[i][3]; }
    sa = wave_sum(sa); sb = wave_sum(sb);
    const float ra = rsqrtf(sa * (1.0f / 1024.0f) + 1e-6f), rb = rsqrtf(sb * (1.0f / 1024.0f) + 1e-6f);
    const int mia = mod_index(row), mib = mod_index(rowb);
    if (mia != cmi) { cmi = mia; const float* ma = mod + (size_t)mia * 6144;
#pragma unroll
      for (int i = 0; i < 4; ++i) { const int cc = (i >> 1) * 512 + lane * 8 + (i & 1) * 4; scv[i] = *(const f32x4*)(ma + sc_off + cc) + 1.0f; shv[i] = *(const f32x4*)(ma + sh_off + cc); } }
    f32x4 scb[4], shb[4];
#pragma unroll
    for (int i = 0; i < 4; ++i) { scb[i] = scv[i]; shb[i] = shv[i]; }
    if (mib != mia) { const float* mb = mod + (size_t)mib * 6144;
#pragma unroll
      for (int i = 0; i < 4; ++i) { const int cc = (i >> 1) * 512 + lane * 8 + (i & 1) * 4; scb[i] = *(const f32x4*)(mb + sc_off + cc) + 1.0f; shb[i] = *(const f32x4*)(mb + sh_off + cc); } }
#pragma unroll
    for (int h2 = 0; h2 < 2; ++h2) { const int cc = h2 * 512 + lane * 8;
      const f32x4 oa0 = va[2 * h2] * ra * gv[2 * h2] * scv[2 * h2] + shv[2 * h2], oa1 = va[2 * h2 + 1] * ra * gv[2 * h2 + 1] * scv[2 * h2 + 1] + shv[2 * h2 + 1];
      const f32x4 ob0 = vb[2 * h2] * rb * gv[2 * h2] * scb[2 * h2] + shb[2 * h2], ob1 = vb[2 * h2 + 1] * rb * gv[2 * h2 + 1] * scb[2 * h2 + 1] + shb[2 * h2 + 1];
      u32x4 pa, pb; pa[0] = cvt_pk_bf16(oa0[0], oa0[1]); pa[1] = cvt_pk_bf16(oa0[2], oa0[3]); pa[2] = cvt_pk_bf16(oa1[0], oa1[1]); pa[3] = cvt_pk_bf16(oa1[2], oa1[3]);
      pb[0] = cvt_pk_bf16(ob0[0], ob0[1]); pb[1] = cvt_pk_bf16(ob0[2], ob0[3]); pb[2] = cvt_pk_bf16(ob1[0], ob1[1]); pb[3] = cvt_pk_bf16(ob1[2], ob1[3]);
      *(u32x4*)(dst + (size_t)row * DM + cc) = pa; if (rowb != row) *(u32x4*)(dst + (size_t)rowb * DM + cc) = pb; }
  }
}

__device__ __forceinline__ unsigned cvt_pk_bf16_p(float lo, float hi) { return cvt_pk_bf16(lo, hi); }
__device__ __forceinline__ float fsigmoid(float x) { return __builtin_amdgcn_rcpf(1.0f + __expf(-x)); }
constexpr int AVP = 136;
constexpr int KBP = 1040, VVP = 528;
constexpr int SC_AV = 0, SC_KB = 128 * AVP, SC_WW = SC_KB + 16 * KBP, SC_VV = SC_WW + 4096, SC_CC = SC_VV + 16 * VVP, SC_BUFB = SC_CC + 2048;
constexpr int SC_YB = 2 * SC_BUFB;
constexpr int GSP = 32 * AVP;
constexpr int SC_GS = SC_YB + 16640;
constexpr int SC_WT = SC_GS + 4 * GSP;
constexpr int SC_CT = SC_WT + 2 * 64 * 144;
constexpr int SC_END = SC_CT + 1280;
struct CSetP { u32x4 A0, A1, A2, A3; };
struct PLoad { bf16x8 a00, a01, a10, a11; u32x4 k[2], r[2]; };
template <int DIR>
__device__ void scan_unit(const Params& p, LAS unsigned char* lds, int h, int half, int tb0, int n0, const float* s0,
                          int tb1, int tbstride, int n1, int nseg1, float* so1, size_t sostride, bf16_t* ydst, bool bgconv) {
  constexpr int dir = DIR;
  const int tid = opaque_tid(), lane = tid & 63, wid = __builtin_amdgcn_readfirstlane(tid >> 6);
  const int c = lane & 15, q = lane >> 4;
  const int nch = n0 + n1 * nseg1;
#define SC_TB(g_) (((g_) < n0) ? (tb0 + (DIR ? (n0 - 1 - (g_)) : (g_)) * 64) \
                               : (tb1 + (((g_) - n0) / n1) * tbstride + (DIR ? (n1 - 1 - (((g_) - n0) % n1)) : (((g_) - n0) % n1)) * 64))
  if (wid < 2) {
    __builtin_amdgcn_s_setprio(3);
    const int rowl = wid * 16 + c, rg = half * 32 + rowl;
    f32x4 acc0, acc1, acc2, acc3;
    if (s0 && n0 > 0) { const float* sp = s0 + rg * 64 + 4 * q; acc0 = *(const f32x4*)(sp); acc1 = *(const f32x4*)(sp + 16); acc2 = *(const f32x4*)(sp + 32); acc3 = *(const f32x4*)(sp + 48); }
    else { acc0 = acc1 = acc2 = acc3 = (f32x4){0.f, 0.f, 0.f, 0.f}; }
    CSetP SA, SB;
    for (int ci = 0; ci < nch; ++ci) {
      __syncthreads();
      if (ci >= n0 && ci > 0 && ((ci - n0) % n1) == 0) acc0 = acc1 = acc2 = acc3 = (f32x4){0.f, 0.f, 0.f, 0.f};
      LAS unsigned char* B = lds + (ci & 1) * SC_BUFB;
      LAS float* yb = (LAS float*)(lds + SC_YB) + (ci & 1) * (32 * 65) + rowl * 65;
      LAS unsigned char* pA = B + SC_AV + (c & 3) * AVP + 8 * q;
      LAS unsigned char* pW = B + SC_WW + 16 * q;
      LAS unsigned char* pK = B + SC_KB + 16 * c;
      LAS unsigned char* pV = B + SC_VV + 16 * rowl;
      LAS unsigned char* pC = B + SC_CC;
      LAS unsigned char* pE = B + SC_CC + 512 + (c & 3) * 8;
      LAS unsigned char* pY = B + SC_CC + 1024 + (c & 3) * 16;
#define SC_RL(s_) (DIR ? (15 - (s_)) : (s_))
#define SC_LDP(o, rl_) do { const int _r = (rl_) * (8 * AVP); \
      { const u32x2 _x0 = *(const LAS u32x2*)(pA + _r), _x1 = *(const LAS u32x2*)(pA + _r + 32), _x2 = *(const LAS u32x2*)(pA + _r + 64), _x3 = *(const LAS u32x2*)(pA + _r + 96); \
        const u32x2 _x4 = *(const LAS u32x2*)(pA + _r + 4 * AVP), _x5 = *(const LAS u32x2*)(pA + _r + 4 * AVP + 32), _x6 = *(const LAS u32x2*)(pA + _r + 4 * AVP + 64), _x7 = *(const LAS u32x2*)(pA + _r + 4 * AVP + 96); \
        o.A0[0] = _x0[0]; o.A0[1] = _x0[1]; o.A0[2] = _x1[0]; o.A0[3] = _x1[1]; o.A1[0] = _x2[0]; o.A1[1] = _x2[1]; o.A1[2] = _x3[0]; o.A1[3] = _x3[1]; \
        o.A2[0] = _x4[0]; o.A2[1] = _x4[1]; o.A2[2] = _x5[0]; o.A2[3] = _x5[1]; o.A3[0] = _x6[0]; o.A3[1] = _x6[1]; o.A3[2] = _x7[0]; o.A3[3] = _x7[1]; } } while (0)
#define SC_ROUND(C, N, ri_, rnx_) do { const int _rl = SC_RL(ri_); \
      SC_LDP(N, SC_RL(rnx_)); \
      const u32x4 K0 = *(const LAS u32x4*)(pK + _rl * KBP), K1 = *(const LAS u32x4*)(pK + _rl * KBP + 256), K2 = *(const LAS u32x4*)(pK + _rl * KBP + 512), K3 = *(const LAS u32x4*)(pK + _rl * KBP + 768); \
      const f32x4 vv = *(const LAS f32x4*)(pV + _rl * VVP); \
      const f32x4 e2a = *(const LAS f32x4*)(pC + _rl * 32), e2b = *(const LAS f32x4*)(pC + _rl * 32 + 16); \
      const u32x2 eva = *(const LAS u32x2*)(pE + _rl * 32); const u32x4 evy = *(const LAS u32x4*)(pY + _rl * 64); \
      asm volatile("" ::: "memory"); \
        \
      u32x4 b0, b1; \
      b0[0] = cvt_pk_bf16_p(acc0[0], acc0[1]); b0[1] = cvt_pk_bf16_p(acc0[2], acc0[3]); b0[2] = cvt_pk_bf16_p(acc1[0], acc1[1]); b0[3] = cvt_pk_bf16_p(acc1[2], acc1[3]); \
      const f32x4 zz = {0.f, 0.f, 0.f, 0.f}; \
      f32x4 dA = __builtin_amdgcn_mfma_f32_16x16x32_bf16(__builtin_bit_cast(bf16x8, C.A0), __builtin_bit_cast(bf16x8, b0), zz, 0, 0, 0); \
      f32x4 dB = __builtin_amdgcn_mfma_f32_16x16x32_bf16(__builtin_bit_cast(bf16x8, C.A2), __builtin_bit_cast(bf16x8, b0), zz, 0, 0, 0); \
      b1[0] = cvt_pk_bf16_p(acc2[0], acc2[1]); b1[1] = cvt_pk_bf16_p(acc2[2], acc2[3]); b1[2] = cvt_pk_bf16_p(acc3[0], acc3[1]); b1[3] = cvt_pk_bf16_p(acc3[2], acc3[3]); \
      dA = __builtin_amdgcn_mfma_f32_16x16x32_bf16(__builtin_bit_cast(bf16x8, C.A1), __builtin_bit_cast(bf16x8, b1), dA, 0, 0, 0); \
      dB = __builtin_amdgcn_mfma_f32_16x16x32_bf16(__builtin_bit_cast(bf16x8, C.A3), __builtin_bit_cast(bf16x8, b1), dB, 0, 0, 0); \
      const float v1 = vv[0], v2 = vv[1], v3 = vv[2], v4 = vv[3]; \
      { const unsigned be0 = cvt_pk_bf16_p(v1, v2), be1 = cvt_pk_bf16_p(v3, v4); \
        const u32x4 bev = {(q == 0) ? be0 : 0u, (q == 0) ? be1 : 0u, 0u, 0u}; const u32x4 ae0 = {eva[0], eva[1], 0u, 0u}; \
          \
        dA = __builtin_amdgcn_mfma_f32_16x16x32_bf16(__builtin_bit_cast(bf16x8, ae0), __builtin_bit_cast(bf16x8, bev), dA, 0, 0, 0); } \
      const float psa1 = dA[0]; \
      const float psa2 = dA[1] + psa1 * e2a[0];     \
      const float psa3 = dA[2] + psa1 * e2a[1] + psa2 * e2a[2]; \
      const float psa4 = dA[3] + psa1 * e2a[3] + psa2 * e2b[0] + psa3 * e2b[1]; \
      u32x4 bbv; \
      { const unsigned bd1 = cvt_pk_bf16_p(v1, psa1), bd2 = cvt_pk_bf16_p(v2, psa2), bd3 = cvt_pk_bf16_p(v3, psa3), bd4 = cvt_pk_bf16_p(v4, psa4);     \
        bbv[0] = (q == 0) ? bd1 : 0u; bbv[1] = (q == 0) ? bd2 : 0u; bbv[2] = (q == 0) ? bd3 : 0u; bbv[3] = (q == 0) ? bd4 : 0u; } \
      const bf16x8 bb = __builtin_bit_cast(bf16x8, bbv); \
        \
      dB = __builtin_amdgcn_mfma_f32_16x16x32_bf16(__builtin_bit_cast(bf16x8, evy), bb, dB, 0, 0, 0); \
      acc0 = __builtin_amdgcn_mfma_f32_16x16x32_bf16(__builtin_bit_cast(bf16x8, K0), bb, acc0, 0, 0, 0); \
      acc1 = __builtin_amdgcn_mfma_f32_16x16x32_bf16(__builtin_bit_cast(bf16x8, K1), bb, acc1, 0, 0, 0); \
      acc2 = __builtin_amdgcn_mfma_f32_16x16x32_bf16(__builtin_bit_cast(bf16x8, K2), bb, acc2, 0, 0, 0); \
      acc3 = __builtin_amdgcn_mfma_f32_16x16x32_bf16(__builtin_bit_cast(bf16x8, K3), bb, acc3, 0, 0, 0); \
      { const float ya = (q & 1) ? dB[1] : dB[0], ybv = (q & 1) ? dB[3] : dB[2]; yb[DIR ? (4 * _rl + 3 - q) : (4 * _rl + q)] = (q & 2) ? ybv : ya; } \
      asm volatile("" ::: "memory"); __builtin_amdgcn_sched_barrier(0); } while (0)
      SC_LDP(SA, SC_RL(0));
      for (int g = 0; g < 8; ++g) {
        const int r0 = g * 2; const int rlast = (r0 + 2 < 16) ? (r0 + 2) : 15;
        f32x4 wt0, wt1, wt2, wt3;
        if (g & 1) { const int tl = SC_RL(r0) >> 2;
          wt0 = *(const LAS f32x4*)(pW + tl * 256); wt1 = *(const LAS f32x4*)(pW + tl * 256 + 64); wt2 = *(const LAS f32x4*)(pW + tl * 256 + 128); wt3 = *(const LAS f32x4*)(pW + tl * 256 + 192); }
        SC_ROUND(SA, SB, r0, r0 + 1);
        SC_ROUND(SB, SA, r0 + 1, rlast);
        if (g & 1) { acc0 *= wt0; acc1 *= wt1; acc2 *= wt2; acc3 *= wt3; }
      }
      if (ci >= n0 && ((ci - n0) % n1) == n1 - 1) {
        float* sp = so1 + (size_t)((ci - n0) / n1) * sostride + rg * 64 + 4 * q; *(f32x4*)(sp) = acc0; *(f32x4*)(sp + 16) = acc1; *(f32x4*)(sp + 32) = acc2; *(f32x4*)(sp + 48) = acc3; }
    }
    __syncthreads();
    __builtin_amdgcn_s_setprio(0);
#undef SC_LDP
#undef SC_ROUND
#undef SC_RL
  } else if (wid == 4 || wid == 5) {
    const int L = (wid - 4) * 64 + lane, ft = L >> 1, rh = L & 1;
    const bf16_t* Uq = (const bf16_t*)(p.ws + WS_U); bf16_t* CBq = (bf16_t*)(p.ws + WS_CB);
    float cw0[8], cw1[8], cw2[8];
    if (bgconv) {
#pragma unroll
      for (int i = 0; i < 8; ++i) { cw0[i] = p.in[21][L * 8 + i]; cw1[i] = p.in[21][1024 + L * 8 + i]; cw2[i] = p.in[21][2048 + L * 8 + i]; } }
    LAS float* tsc = (LAS float*)(lds + SC_TT) + (wid - 4) * 1056;
    const bf16_t* Vq = (const bf16_t*)(p.ws + WS_V);
#define FL_VVFILL(g_) do { const int _tb = SC_TB(g_); LAS unsigned char* _B = lds + ((g_) & 1) * SC_BUFB; const int _tl = L >> 1, _rh = L & 1; \
      const bf16_t* _vp = Vq + (size_t)(_tb + _tl) * DM + h * 64 + half * 32 + _rh * 16; const u32x4 _v0 = *(const u32x4*)(_vp), _v1 = *(const u32x4*)(_vp + 8); \
      const int _js = DIR ? (3 - (_tl & 3)) : (_tl & 3); LAS unsigned char* _wp = _B + SC_VV + (_tl >> 2) * VVP + ((_rh * 16) * 4 + _js) * 4; \
      _Pragma("unroll") for (int i = 0; i < 4; ++i) { *(LAS float*)(_wp + (2 * i) * 16) = lo_bf(_v0[i]); *(LAS float*)(_wp + (2 * i + 1) * 16) = hi_bf(_v0[i]); \
        *(LAS float*)(_wp + (8 + 2 * i) * 16) = lo_bf(_v1[i]); *(LAS float*)(_wp + (8 + 2 * i + 1) * 16) = hi_bf(_v1[i]); } } while (0)
    if (nch > 0) FL_VVFILL(0);
    for (int ci = 0; ci <= nch; ++ci) {
      __syncthreads();
      if (ci + 1 < nch) FL_VVFILL(ci + 1);
#define BG_TRANSPOSE(src_, srcN_, dst_, Kd_, jt_) do { const int _nkt = (Kd_) / 32; const int _o0 = ((jt_) / _nkt) * 32, _k0 = ((jt_) % _nkt) * 32; \
        { const int kr = lane >> 3, oc = (lane & 7) * 4; \
          _Pragma("unroll") for (int pz = 0; pz < 4; ++pz) { const f32x4 v = *(const f32x4*)((src_) + (size_t)(_k0 + kr + 8 * pz) * (srcN_) + _o0 + oc); \
            LAS float* tp = tsc + (kr + 8 * pz) * 33 + oc; tp[0] = v[0]; tp[1] = v[1]; tp[2] = v[2]; tp[3] = v[3]; } } \
        { const int oo = lane & 31, kh = lane >> 5; float w[16]; \
          _Pragma("unroll") for (int i = 0; i < 16; ++i) w[i] = tsc[(kh * 16 + i) * 33 + oo]; \
          u32x4 a, b2; \
          _Pragma("unroll") for (int i = 0; i < 4; ++i) { a[i] = cvt_pk_bf16(w[2 * i], w[2 * i + 1]); b2[i] = cvt_pk_bf16(w[8 + 2 * i], w[8 + 2 * i + 1]); } \
          bf16_t* dp = (dst_) + (size_t)(_o0 + oo) * (Kd_) + _k0 + kh * 16; *(u32x4*)(dp) = a; *(u32x4*)(dp + 8) = b2; } } while (0)
      if (bgconv && ci < 80 && (ci % 5) == 0) {
        const int job = (blockIdx.x * 2 + (wid - 4)) * 16 + ci / 5;
        const bool second = job >= 4096; const int jt = second ? job - 4096 : job;
        const float* src = second ? p.in[26] : p.in[25]; const int srcN = second ? 1024 : 4096, Kd = second ? 4096 : 1024;
        bf16_t* dstw = (bf16_t*)(p.ws + (second ? WS_WFF2 : WS_WFF1));
        BG_TRANSPOSE(src, srcN, dstw, Kd, jt);
      }
      if (bgconv && ci < 35 && (ci % 5) == 2) {
        const int job = (blockIdx.x * 2 + (wid - 4)) * 7 + ci / 5;
        if (job < 3072) { const int which = job >> 10, jt = job & 1023;
          const float* src = (which == 0) ? p.in[22] : (which == 1) ? p.in[23] : p.in[24];
          bf16_t* dstw = (bf16_t*)(p.ws + WS_WPA) + (size_t)which * 1024 * 1024;
          BG_TRANSPOSE(src, 1024, dstw, 1024, jt);
        } else if (job < 3200) { const int jt = job - 3072;
          BG_TRANSPOSE(p.in[15], 1024, (bf16_t*)(p.ws + WS_G2T), 128, jt); }
      }
#undef BG_TRANSPOSE
      if (bgconv && ci < 80) {
        const int tok = blockIdx.x * 80 + ci; const int Wm = (tok < NCTX) ? 255 : 63; const int pos = tok & Wm;
        const size_t off = (size_t)tok * DM + L * 8;
        const u32x4 uc = *(const u32x4*)(Uq + off), cbv = *(const u32x4*)(CBq + off);
        u32x4 up = {0u, 0u, 0u, 0u}, un = {0u, 0u, 0u, 0u};
        if (pos != 0) up = *(const u32x4*)(Uq + off - DM);
        if (pos != Wm) un = *(const u32x4*)(Uq + off + DM);
        float o[8];
#pragma unroll
        for (int i = 0; i < 4; ++i) {
          o[2 * i] = lo_bf(cbv[i]) * (cw0[2 * i] * lo_bf(up[i]) + cw1[2 * i] * lo_bf(uc[i]) + cw2[2 * i] * lo_bf(un[i]));
          o[2 * i + 1] = hi_bf(cbv[i]) * (cw0[2 * i + 1] * hi_bf(up[i]) + cw1[2 * i + 1] * hi_bf(uc[i]) + cw2[2 * i + 1] * hi_bf(un[i]));
        }
        u32x4 ob; ob[0] = cvt_pk_bf16(o[0], o[1]); ob[1] = cvt_pk_bf16(o[2], o[3]); ob[2] = cvt_pk_bf16(o[4], o[5]); ob[3] = cvt_pk_bf16(o[6], o[7]);
        *(u32x4*)(CBq + off) = ob;
      }
      if (ci >= 1) {
        const int cj = ci - 1, tb = SC_TB(cj);
        const LAS float* yb = (const LAS float*)(lds + SC_YB) + (cj & 1) * (32 * 65) + (rh * 16) * 65 + ft;
        float yv[16];
#pragma unroll
        for (int i = 0; i < 16; ++i) yv[i] = yb[i * 65];
        u32x4 o0, o1;
#pragma unroll
        for (int i = 0; i < 4; ++i) { o0[i] = cvt_pk_bf16(yv[2 * i], yv[2 * i + 1]); o1[i] = cvt_pk_bf16(yv[8 + 2 * i], yv[8 + 2 * i + 1]); }
        bf16_t* dp = ydst + (size_t)(tb + ft) * DM + h * 64 + half * 32 + rh * 16;
        *(u32x4*)(dp) = o0; *(u32x4*)(dp + 8) = o1;
      }
    }
  } else {
    const int pw = (wid & 1) + ((wid >> 2) << 1), t0 = pw * 16;
    const bf16_t* Rr = (const bf16_t*)(p.ws + WS_R); const bf16_t* Kr = (const bf16_t*)(p.ws + WS_K); const bf16_t* Vr = (const bf16_t*)(p.ws + WS_V);
    const bf16_t* LOR = (const bf16_t*)(p.ws + WS_LOR);
    float* C3 = (float*)(p.ws + WS_C3);
    LAS float* CT = (LAS float*)(lds + SC_CT);
    LAS unsigned char* WT = lds + SC_WT;
    LAS unsigned char* GS = lds + SC_GS + pw * GSP;
    { const int ch = h * 64 + lane;
      CT[lane] = p.in[11][dir * 1024 + ch]; CT[64 + lane] = p.in[13][dir * 1024 + ch]; CT[128 + lane] = p.in[16][ch]; CT[192 + lane] = p.in[17][ch]; CT[256 + lane] = p.in[18][ch];
#pragma unroll 2
      for (int i = 0; i < 16; ++i) { const int e = i * 64 + lane; const int sel = e >> 9, row = (e >> 3) & 63, seg = e & 7;
        const u32x4 wv = *(const u32x4*)((const bf16_t*)(p.ws + (sel ? WS_A2T : WS_W2T)) + ((size_t)(dir * 1024 + h * 64 + row)) * 64 + seg * 8);
        *(LAS u32x4*)(WT + (sel * 64 + row) * 144 + seg * 16) = wv; } }
    const int js = DIR ? (3 - (c & 3)) : (c & 3);
#define SC_PLD_A(o, ci_) do { const size_t _tok = (size_t)(SC_TB(ci_) + t0 + c); \
      const bf16_t* _ap = LOR + _tok * 384 + dir * 64 + q * 8; \
      o.a00 = *(const bf16x8*)(_ap); o.a01 = *(const bf16x8*)(_ap + 32); o.a10 = *(const bf16x8*)(_ap + 128); o.a11 = *(const bf16x8*)(_ap + 160); } while (0)
#define SC_PLD_K(o, ci_) do { const size_t _tok = (size_t)(SC_TB(ci_) + t0 + c); \
      const size_t _to = _tok * DM + h * 64; \
      o.k[0] = *(const u32x4*)(Kr + _to + q * 16); o.k[1] = *(const u32x4*)(Kr + _to + q * 16 + 8); o.r[0] = *(const u32x4*)(Rr + _to + q * 16); o.r[1] = *(const u32x4*)(Rr + _to + q * 16 + 8); } while (0)
    PLoad cur; SC_PLD_A(cur, 0); SC_PLD_K(cur, 0);
    for (int ci = 0; ci < nch; ++ci) {
      const int tb = SC_TB(ci);
      LAS unsigned char* B = lds + (ci & 1) * SC_BUFB;
      const int cn = (ci + 1 < nch) ? (ci + 1) : ci;
      const int t = t0 + c, rho = t >> 2;
      float ss = 0.f, c1 = 0.f, c2 = 0.f, c3 = 0.f;
      f32x4 decr[4], avr[4], kkr4[4], kdr4[4], rfr4[4];
#pragma unroll
      for (int nt = 0; nt < 4; ++nt) {
        const int wrow = (c >> 2) * 16 + nt * 4 + (c & 3);
        const bf16x8 w0f = *(const LAS bf16x8*)(WT + wrow * 144 + q * 16), w1f = *(const LAS bf16x8*)(WT + wrow * 144 + 64 + q * 16);
        const bf16x8 a0f = *(const LAS bf16x8*)(WT + (64 + wrow) * 144 + q * 16), a1f = *(const LAS bf16x8*)(WT + (64 + wrow) * 144 + 64 + q * 16);
        f32x4 X = {0.f, 0.f, 0.f, 0.f}, Y = {0.f, 0.f, 0.f, 0.f};
        X = __builtin_amdgcn_mfma_f32_16x16x32_bf16(w0f, cur.a00, X, 0, 0, 0); X = __builtin_amdgcn_mfma_f32_16x16x32_bf16(w1f, cur.a01, X, 0, 0, 0);
        Y = __builtin_amdgcn_mfma_f32_16x16x32_bf16(a0f, cur.a10, Y, 0, 0, 0); Y = __builtin_amdgcn_mfma_f32_16x16x32_bf16(a1f, cur.a11, Y, 0, 0, 0);
        const int kb = q * 16 + nt * 4;
        const f32x4 tw0 = *(const LAS f32x4*)(CT + kb), ta0 = *(const LAS f32x4*)(CT + 64 + kb), tkk = *(const LAS f32x4*)(CT + 128 + kb), tka = *(const LAS f32x4*)(CT + 192 + kb), trk = *(const LAS f32x4*)(CT + 256 + kb);
        const unsigned kq0 = cur.k[nt >> 1][(nt & 1) * 2], kq1 = cur.k[nt >> 1][(nt & 1) * 2 + 1], rq0 = cur.r[nt >> 1][(nt & 1) * 2], rq1 = cur.r[nt >> 1][(nt & 1) * 2 + 1];
        const float kf[4] = {lo_bf(kq0), hi_bf(kq0), lo_bf(kq1), hi_bf(kq1)};
        const float rf[4] = {lo_bf(rq0), hi_bf(rq0), lo_bf(rq1), hi_bf(rq1)};
#pragma unroll
        for (int j = 0; j < 4; ++j) {
          decr[nt][j] = __expf(-0.6065306597126334f * fsigmoid(tw0[j] + X[j]));
          const float av = fsigmoid(ta0[j] + Y[j]); avr[nt][j] = av;
          const float kr_ = kf[j] * tkk[j]; ss += kr_ * kr_;
          const float kd = kf[j] * (1.0f + (av - 1.0f) * tka[j]);
          kkr4[nt][j] = kr_; kdr4[nt][j] = kd; rfr4[nt][j] = rf[j];
          c1 += kd * rf[j]; c3 += rf[j] * kd * trk[j];
        }
      }
      SC_PLD_A(cur, cn);
      ss += __shfl_xor(ss, 16); ss += __shfl_xor(ss, 32);
      const float inv = rsqrtf(fmaxf(ss, 1e-12f));
#pragma unroll
      for (int nt = 0; nt < 4; ++nt) {
        const int kb = q * 16 + nt * 4;
        const f32x4 rf = rfr4[nt];
        float kkt[4], wrt[4], kdt[4], bt[4]; f32x4 pin;
#pragma unroll
        for (int j = 0; j < 4; ++j) {
          const float dec = decr[nt][j], av = avr[nt][j];
          const float kk = kkr4[nt][j] * inv, bv = -(kk * av), kd = kdr4[nt][j];
          c2 += bv * rf[j];
          float Pin = dec;
          Pin *= DIR ? dppo<0x101>(1.0f, Pin) : dppo<0x111>(1.0f, Pin);
          Pin *= DIR ? dppo<0x102>(1.0f, Pin) : dppo<0x112>(1.0f, Pin);
          Pin *= DIR ? dppo<0x104>(1.0f, Pin) : dppo<0x114>(1.0f, Pin);
          Pin *= DIR ? dppo<0x108>(1.0f, Pin) : dppo<0x118>(1.0f, Pin);
          const float Pex = DIR ? dppo<0x101>(1.0f, Pin) : dppo<0x111>(1.0f, Pin);
          const float rP = __builtin_amdgcn_rcpf(Pin);
          kkt[j] = kk * Pex; wrt[j] = rf[j] * Pin; kdt[j] = kd * rP; bt[j] = bv * rP; pin[j] = Pin;
          *(LAS unsigned*)(B + SC_KB + rho * KBP + ((kb + j) * 4 + js) * 4) = cvt_pk_bf16(kdt[j], bt[j]);
        }
        { u32x2 o; o[0] = cvt_pk_bf16(kkt[0], kkt[1]); o[1] = cvt_pk_bf16(kkt[2], kkt[3]); *(LAS u32x2*)(B + SC_AV + (rho * 8 + js) * AVP + kb * 2) = o; }
        { u32x2 o; o[0] = cvt_pk_bf16(wrt[0], wrt[1]); o[1] = cvt_pk_bf16(wrt[2], wrt[3]); *(LAS u32x2*)(B + SC_AV + (rho * 8 + 4 + js) * AVP + kb * 2) = o; }
        { u32x2 o; o[0] = cvt_pk_bf16(kdt[0], kdt[1]); o[1] = cvt_pk_bf16(kdt[2], kdt[3]); *(LAS u32x2*)(GS + (c * 2 + 0) * AVP + kb * 2) = o; }
        { u32x2 o; o[0] = cvt_pk_bf16(bt[0], bt[1]); o[1] = cvt_pk_bf16(bt[2], bt[3]); *(LAS u32x2*)(GS + (c * 2 + 1) * AVP + kb * 2) = o; }
        if ((DIR ? (15 - c) : c) == 15) *(LAS f32x4*)(B + SC_WW + (pw * 64 + kb) * 4) = pin;
      }
      c1 += __shfl_xor(c1, 16); c1 += __shfl_xor(c1, 32); c2 += __shfl_xor(c2, 16); c2 += __shfl_xor(c2, 32); c3 += __shfl_xor(c3, 16); c3 += __shfl_xor(c3, 32);
      LAS float* cp = (LAS float*)(B + SC_CC + rho * 32);
      LAS unsigned short* eva = (LAS unsigned short*)(B + SC_CC + 512 + rho * 32);
      LAS unsigned short* evy = (LAS unsigned short*)(B + SC_CC + 1024 + rho * 64);
      if (q == 0 && half == 0) C3[((size_t)dir * NT + tb + t) * 16 + h] = c3;
      { const LAS unsigned char* ap = B + SC_AV + (rho * 8 + js) * AVP + 16 * q;
        const LAS unsigned char* gp = GS + (c * 2) * AVP + 16 * q;
#define SC_LD16(p_) ({ const u32x2 _a = *(const LAS u32x2*)(p_), _b = *(const LAS u32x2*)((p_) + 8); const u32x4 _v = {_a[0], _a[1], _b[0], _b[1]}; __builtin_bit_cast(bf16x8, _v); })
        const bf16x8 akk0 = SC_LD16(ap), akk1 = SC_LD16(ap + 64), awr0 = SC_LD16(ap + 4 * AVP), awr1 = SC_LD16(ap + 4 * AVP + 64);
        const bf16x8 bkd0 = SC_LD16(gp), bkd1 = SC_LD16(gp + 64), bb0 = SC_LD16(gp + AVP), bb1 = SC_LD16(gp + AVP + 64);
#undef SC_LD16
        const f32x4 zz = {0.f, 0.f, 0.f, 0.f};
        f32x4 gE1 = __builtin_amdgcn_mfma_f32_16x16x32_bf16(akk0, bkd0, zz, 0, 0, 0); gE1 = __builtin_amdgcn_mfma_f32_16x16x32_bf16(akk1, bkd1, gE1, 0, 0, 0);
        f32x4 gE2 = __builtin_amdgcn_mfma_f32_16x16x32_bf16(akk0, bb0, zz, 0, 0, 0);  gE2 = __builtin_amdgcn_mfma_f32_16x16x32_bf16(akk1, bb1, gE2, 0, 0, 0);
        f32x4 gF1 = __builtin_amdgcn_mfma_f32_16x16x32_bf16(awr0, bkd0, zz, 0, 0, 0); gF1 = __builtin_amdgcn_mfma_f32_16x16x32_bf16(awr1, bkd1, gF1, 0, 0, 0);
        f32x4 gF2 = __builtin_amdgcn_mfma_f32_16x16x32_bf16(awr0, bb0, zz, 0, 0, 0);  gF2 = __builtin_amdgcn_mfma_f32_16x16x32_bf16(awr1, bb1, gF2, 0, 0, 0);
        if (q == (c >> 2)) {
#pragma unroll
          for (int jj = 0; jj < 4; ++jj) { const int jsj = DIR ? (3 - jj) : jj;
            const float eE = (jsj > js) ? gE1[jj] : 0.f;
            const float eFv = (jsj > js) ? gF1[jj] : ((jsj == js) ? c1 : 0.f);
            const float eFp = (jsj > js) ? gF2[jj] : ((jsj == js) ? c2 : 0.f);
            eva[jsj * 4 + js] = (unsigned short)(cvt_pk_bf16(eE, 0.f) & 0xffffu);
            *(LAS unsigned*)(evy + jsj * 8 + 2 * js) = cvt_pk_bf16(eFv, eFp);
            if (jsj > js) { const int idx = jsj * (jsj - 1) / 2 + js; cp[idx] = gE2[jj]; } }
        }
      }
      SC_PLD_K(cur, cn);
      __syncthreads();
    }
    __syncthreads();
#undef SC_PLD_A
#undef SC_PLD_K
  }
  __syncthreads();
#undef SC_TB
}

#define XB_TMO      128
#define XB_XCNT(j)  (256  + 64 * (j))
#define XB_XSUB(j)  (1280 + 64 * (j))
#define XB_XGEN(j)  (2304 + 64 * (j))
#define XB_TOP      3328
#define XB_TOPGEN   3392
#define XCD_BAR_WORDS 3456
#define XB_SPIN_CAP (1u << 18)
__device__ __forceinline__ unsigned xb_ld(unsigned* p)              { return __hip_atomic_load(p, __ATOMIC_RELAXED, __HIP_MEMORY_SCOPE_AGENT); }
__device__ __forceinline__ unsigned xb_add(unsigned* p, unsigned v) { return __hip_atomic_fetch_add(p, v, __ATOMIC_RELAXED, __HIP_MEMORY_SCOPE_AGENT); }
__device__ __forceinline__ unsigned xb_xcc_id() { return (unsigned)__builtin_amdgcn_s_getreg((3 << 11) | 20) & 0xFu; }
#define XB_SPIN(cond, bar) do { unsigned _sp = 0; while (cond) { __builtin_amdgcn_s_sleep(1); \
    if ((++_sp & 255u) == 0u) { if (xb_ld(&(bar)[XB_TMO])) break; if (_sp > XB_SPIN_CAP) { atomicAdd(&(bar)[XB_TMO], 1u); break; } } } } while (0)
struct XcdBarrier { unsigned* bar; unsigned x; volatile LAS unsigned* st; };
__device__ __forceinline__ XcdBarrier xcd_barrier_post(unsigned* bar, volatile LAS unsigned* st) {
  XcdBarrier b; b.bar = bar; b.x = xb_xcc_id(); b.st = st;
  if (threadIdx.x == 0) (void)xb_add(&bar[XB_XCNT(b.x)], 1u);
  return b;
}
__device__ __forceinline__ void xcd_barrier_complete(unsigned* bar, unsigned x, unsigned& nloc, unsigned& nx) {
  const unsigned G = gridDim.x * gridDim.y * gridDim.z;
  unsigned sum, cnt, mine, sp = 0u;
  for (;;) {
    sum = 0u; cnt = 0u; mine = 0u;
#pragma unroll
    for (unsigned j = 0; j < 16; ++j) { const unsigned c = xb_ld(&bar[XB_XCNT(j)]); sum += c; cnt += (c > 0u) ? 1u : 0u; mine = (j == x) ? c : mine; }
    if (sum == G) break;
    __builtin_amdgcn_s_sleep(1);
    if ((++sp & 255u) == 0u) { if (xb_ld(&bar[XB_TMO])) break; if (sp > XB_SPIN_CAP) { atomicAdd(&bar[XB_TMO], 1u); break; } }
  }
  nloc = mine > 0u ? mine : 1u; nx = cnt > 0u ? cnt : 1u;
}
__device__ __forceinline__ void xcd_barrier(const XcdBarrier& b) {
  asm volatile("s_waitcnt vmcnt(0)" ::: "memory");
  __syncthreads();
  if (threadIdx.x == 0) {
    unsigned* bar = b.bar;
    __builtin_amdgcn_s_waitcnt(0);
    unsigned nloc = b.st[0], nx = b.st[1];
    if (nloc == 0u) { xcd_barrier_complete(bar, b.x, nloc, nx); b.st[0] = nloc; b.st[1] = nx; }
    const unsigned old = xb_add(&bar[XB_XSUB(b.x)], 1u);
    const unsigned gen = old / nloc;
    if (old + 1u == (gen + 1u) * nloc) {
      __builtin_amdgcn_fence(__ATOMIC_RELEASE, "agent");
      asm volatile("s_waitcnt vmcnt(0)" ::: "memory");
      const unsigned og = xb_add(&bar[XB_TOP], 1u);
      const unsigned tg = og / nx;
      if (og + 1u == (tg + 1u) * nx) xb_add(&bar[XB_TOPGEN], 1u);
      else XB_SPIN(xb_ld(&bar[XB_TOPGEN]) == tg, bar);
      __builtin_amdgcn_fence(__ATOMIC_ACQUIRE, "agent");
      xb_add(&bar[XB_XGEN(b.x)], 1u);
      asm volatile("s_waitcnt vmcnt(0)" ::: "memory");
    } else {
      XB_SPIN(xb_ld(&bar[XB_XGEN(b.x)]) == gen, bar);
      __builtin_amdgcn_fence(__ATOMIC_ACQUIRE, "agent");
      asm volatile("s_waitcnt vmcnt(0)" ::: "memory");
    }
  }
  __syncthreads();
}

__global__ void __launch_bounds__(512, 2) mega(Params p) {
  extern __shared__ __attribute__((aligned(16))) unsigned char lds_raw[];
  LAS unsigned char* lds = (LAS unsigned char*)lds_raw;
  cg::grid_group grid = cg::this_grid();
  unsigned char* ws = p.ws;
  bf16_t* const rR = (bf16_t*)(ws + WS_R); bf16_t* const rK = (bf16_t*)(ws + WS_K); bf16_t* const rCB = (bf16_t*)(ws + WS_CB);
  bf16_t* const rU = (bf16_t*)(ws + WS_U); bf16_t* const rV = (bf16_t*)(ws + WS_V); bf16_t* const rLOR = (bf16_t*)(ws + WS_LOR);
  bf16_t* const D0 = (bf16_t*)p.out; bf16_t* const D1 = (bf16_t*)((unsigned char*)p.out + RG);
  float* const MODP = (float*)(ws + WS_MODP); float* const MOD = (float*)(ws + WS_MOD);
  const float* xp = p.in[0]; const float* xs = p.in[1];
  pg8::StaticOrder S;
  volatile LAS unsigned* xst = (volatile LAS unsigned*)(lds + XST_OFF);
  if (threadIdx.x < 4) xst[threadIdx.x] = 0u;
  __syncthreads();
  const XcdBarrier xb = xcd_barrier_post((unsigned*)(ws + WS_BAR), xst);

  for (int rep = 0; rep < REP_P0; ++rep) {
    const int tid = opaque_tid();
    LAS float* tile = (LAS float*)lds;
    transpose_job<true>(tile, p.in[10], 8576, (bf16_t*)(ws + WS_WIN), 8704, 1024);
    if (gridDim.x != 256) {
    transpose_job<false>(tile, p.in[22], 1024, (bf16_t*)(ws + WS_WPA), 1024, 1024);
    transpose_job<false>(tile, p.in[23], 1024, (bf16_t*)(ws + WS_WPB), 1024, 1024);
    transpose_job<false>(tile, p.in[24], 1024, (bf16_t*)(ws + WS_WO), 1024, 1024);
    transpose_job<false>(tile, p.in[15], 1024, (bf16_t*)(ws + WS_G2T), 1024, 128); }
    for (int d = 0; d < 2; ++d) {
      transpose_job<false>(tile, p.in[12] + (size_t)d * 64 * 1024, 1024, (bf16_t*)(ws + WS_W2T) + (size_t)d * 1024 * 64, 1024, 64);
      transpose_job<false>(tile, p.in[14] + (size_t)d * 64 * 1024, 1024, (bf16_t*)(ws + WS_A2T) + (size_t)d * 1024 * 64, 1024, 64);
    }
    LAS float* sl = (LAS float*)lds;
    for (int ib = blockIdx.x; ib < 32 * 12; ib += gridDim.x) {
      const int kc = ib / 12, j = (ib % 12) * 512 + tid;
      __syncthreads();
      if (tid < 160) { const int i = tid >> 5, k = kc * 32 + (tid & 31); const float c = (i == 0) ? p.in[5][k] : p.in[4][(i - 1) * 1024 + k]; sl[tid] = c / (1.0f + __expf(-c)); }
      __syncthreads();
      float s[5] = {0.f, 0.f, 0.f, 0.f, 0.f};
      const float* wp = p.in[8] + (size_t)(kc * 32) * 6144 + j;
#pragma unroll 8
      for (int k = 0; k < 32; ++k) { const float w = wp[(size_t)k * 6144];
#pragma unroll
        for (int i = 0; i < 5; ++i) s[i] += sl[i * 32 + k] * w; }
#pragma unroll
      for (int i = 0; i < 5; ++i) MODP[((size_t)kc * 5 + i) * 6144 + j] = s[i];
    }
  }
  if (p.ws == nullptr) grid.sync();
  xcd_barrier(xb);
  for (int idx = blockIdx.x * 512 + opaque_tid(); idx < 5 * 6144; idx += gridDim.x * 512) {
    const int j = idx % 6144; float s = p.in[9][j];
    for (int kc = 0; kc < 32; ++kc) s += MODP[(size_t)kc * 5 * 6144 + idx];
    MOD[idx] = s;
  }
  xcd_barrier(xb);
  norm_rows<0>(xp, xs, p.in[6], MOD, 0, 1024, D0, nullptr);
  xcd_barrier(xb);
  { pg8::Gemm g{D0, (const bf16_t*)(ws + WS_WIN), NT, 6656, 1024, 1024}; S.init(NT, 6656, gridDim.x, blockIdx.x);
    EpiIn E{rR, rK, rV, rCB, rU, rLOR}; pg8::gemm_phase(lds, g, S, E); }
  xcd_barrier(xb);
  {
    const bool stream = (gridDim.x == 256);
    for (int u = blockIdx.x; u < (stream ? 256 : 256 + 1024); u += gridDim.x) {
      int h, dir, half, tb0 = 0, n0 = 0, tb1 = 0, tbs = 0, ns1 = 0; const float* s0 = nullptr; float* so1 = nullptr; size_t sos = 0;
      if (u < 256) { const int b = u >> 6; h = (u >> 2) & 15; dir = (u >> 1) & 1; half = u & 1;
        tb0 = NCTX + b * 4096; n0 = 64; s0 = p.in[2 + dir] + (size_t)(b * 16 + h) * 4096;
        if (stream) { tb1 = b * 256; tbs = 4 * 256; ns1 = 4; sos = (size_t)4 * 16 * 4096;
          so1 = p.out + (size_t)NT * DM + (size_t)dir * (16 * 16 * 4096) + (size_t)(b * 16 + h) * 4096; }
      } else { const int cu = u - 256; const int b = cu >> 6; h = (cu >> 2) & 15; dir = (cu >> 1) & 1; half = cu & 1;
        tb1 = b * 256; ns1 = 1; so1 = p.out + (size_t)NT * DM + (size_t)dir * (16 * 16 * 4096) + (size_t)(b * 16 + h) * 4096; }
      if (dir) scan_unit<1>(p, lds, h, half, tb0, n0, s0, tb1, tbs, 4, ns1, so1, sos, D1, stream);
      else scan_unit<0>(p, lds, h, half, tb0, n0, s0, tb1, tbs, 4, ns1, so1, sos, D0, stream);
    }
  }
  xcd_barrier(xb);
  {
    const int tid = opaque_tid(), lane = tid & 63, wid = tid >> 6;
    const bf16_t* G2T = (const bf16_t*)(ws + WS_G2T); const float* C3 = (const float*)(ws + WS_C3);
    const int gw = blockIdx.x * 8 + wid, nw = gridDim.x * 8; const int tk = lane & 15, q = lane >> 4;
    const int tpw = (NT / 16 + gridDim.x - 1) / gridDim.x;
    for (int rep = 0; rep < REP_P7; ++rep)
    for (int e = 0; e < 2; ++e) {
      const int h = wid * 2 + e;
      bf16x8 gfr[4][4]; f32x4 lw[4], lb[4];
#pragma unroll
      for (int nt = 0; nt < 4; ++nt) { lw[nt] = *(const f32x4*)(p.in[19] + h * 64 + q * 16 + nt * 4); lb[nt] = *(const f32x4*)(p.in[20] + h * 64 + q * 16 + nt * 4);
#pragma unroll
        for (int ks = 0; ks < 4; ++ks) gfr[nt][ks] = *(const bf16x8*)(G2T + (size_t)(h * 64 + (tk >> 2) * 16 + nt * 4 + (tk & 3)) * 128 + ks * 32 + q * 8); }
      for (int k = 0; k < tpw; ++k) {
        const int tt = blockIdx.x * tpw + k; if (tt >= NT / 16) break;
        const int tok = tt * 16 + tk;
        bf16x8 sfr[4];
#pragma unroll
        for (int ks = 0; ks < 4; ++ks) sfr[ks] = *(const bf16x8*)(rLOR + (size_t)tok * 384 + 256 + ks * 32 + q * 8);
        const float c3s = C3[(size_t)tok * 16 + h] + C3[((size_t)NT + tok) * 16 + h];
        const size_t off = (size_t)tok * DM + h * 64 + q * 16;
        const u32x4 yfa = *(const u32x4*)(D0 + off), yfb = *(const u32x4*)(D0 + off + 8), yba = *(const u32x4*)(D1 + off), ybb = *(const u32x4*)(D1 + off + 8);
        const u32x4 va = *(const u32x4*)(rV + off), vb = *(const u32x4*)(rV + off + 8);
        f32x4 go[4]; float wkv[4][4], vv[4][4]; float sm = 0.f;
#pragma unroll
        for (int nt = 0; nt < 4; ++nt) {
          const unsigned yf0 = (nt < 2) ? yfa[2 * nt] : yfb[2 * nt - 4], yf1 = (nt < 2) ? yfa[2 * nt + 1] : yfb[2 * nt - 3];
          const unsigned yb0 = (nt < 2) ? yba[2 * nt] : ybb[2 * nt - 4], yb1 = (nt < 2) ? yba[2 * nt + 1] : ybb[2 * nt - 3];
          const unsigned v0 = (nt < 2) ? va[2 * nt] : vb[2 * nt - 4], v1 = (nt < 2) ? va[2 * nt + 1] : vb[2 * nt - 3];
          f32x4 z = {0.f, 0.f, 0.f, 0.f};
#pragma unroll
          for (int ks = 0; ks < 4; ++ks) z = __builtin_amdgcn_mfma_f32_16x16x32_bf16(gfr[nt][ks], sfr[ks], z, 0, 0, 0);
          go[nt] = z;
          wkv[nt][0] = lo_bf(yf0) + lo_bf(yb0); wkv[nt][1] = hi_bf(yf0) + hi_bf(yb0); wkv[nt][2] = lo_bf(yf1) + lo_bf(yb1); wkv[nt][3] = hi_bf(yf1) + hi_bf(yb1);
          vv[nt][0] = lo_bf(v0); vv[nt][1] = hi_bf(v0); vv[nt][2] = lo_bf(v1); vv[nt][3] = hi_bf(v1);
          sm += wkv[nt][0] + wkv[nt][1] + wkv[nt][2] + wkv[nt][3];
        }
        sm += __shfl_xor(sm, 16); sm += __shfl_xor(sm, 32);
        const float mu = sm * (1.0f / 64.0f); float s2 = 0.f;
#pragma unroll
        for (int nt = 0; nt < 4; ++nt)
#pragma unroll
          for (int j = 0; j < 4; ++j) { const float d = wkv[nt][j] - mu; s2 += d * d; }
        s2 += __shfl_xor(s2, 16); s2 += __shfl_xor(s2, 32);
        const float rs = rsqrtf(s2 * (1.0f / 64.0f) + 64e-5f);
        u32x4 oa, ob2;
#pragma unroll
        for (int nt = 0; nt < 4; ++nt) {
          float o[4];
#pragma unroll
          for (int j = 0; j < 4; ++j) o[j] = ((wkv[nt][j] - mu) * rs * lw[nt][j] + lb[nt][j] + c3s * vv[nt][j]) * go[nt][j];
          const unsigned p0 = cvt_pk_bf16(o[0], o[1]), p1 = cvt_pk_bf16(o[2], o[3]);
          if (nt < 2) { oa[2 * nt] = p0; oa[2 * nt + 1] = p1; } else { ob2[2 * nt - 4] = p0; ob2[2 * nt - 3] = p1; } }
        *(u32x4*)(rR + off) = oa; *(u32x4*)(rR + off + 8) = ob2;
      }
    }
    norm_rows<0>(xp, xs, p.in[6], MOD, 0, 1024, rK, nullptr);
    const float* cw = p.in[21];
    const int rpw = (NT + gridDim.x - 1) / gridDim.x;
    if (gridDim.x != 256) { const int c0 = (tid & 127) * 8;
      float w0[8], w1[8], w2[8];
#pragma unroll
      for (int i = 0; i < 8; ++i) { w0[i] = cw[c0 + i]; w1[i] = cw[1024 + c0 + i]; w2[i] = cw[2048 + c0 + i]; }
      for (int li = tid; li < rpw * 128; li += 512) {
        const int tok = blockIdx.x * rpw + (li >> 7); if (tok >= NT) break;
        const int Wm = (tok < NCTX) ? 255 : 63; const int pos = tok & Wm;
        const size_t off = (size_t)tok * DM + c0;
        const u32x4 uc = *(const u32x4*)(rU + off), cbv = *(const u32x4*)(rCB + off);
        u32x4 up = {0u, 0u, 0u, 0u}, un = {0u, 0u, 0u, 0u};
        if (pos != 0) up = *(const u32x4*)(rU + off - DM);
        if (pos != Wm) un = *(const u32x4*)(rU + off + DM);
        float o[8];
#pragma unroll
        for (int i = 0; i < 4; ++i) {
          o[2 * i] = lo_bf(cbv[i]) * (w0[2 * i] * lo_bf(up[i]) + w1[2 * i] * lo_bf(uc[i]) + w2[2 * i] * lo_bf(un[i]));
          o[2 * i + 1] = hi_bf(cbv[i]) * (w0[2 * i + 1] * hi_bf(up[i]) + w1[2 * i + 1] * hi_bf(uc[i]) + w2[2 * i + 1] * hi_bf(un[i]));
        }
        u32x4 ob; ob[0] = cvt_pk_bf16(o[0], o[1]); ob[1] = cvt_pk_bf16(o[2], o[3]); ob[2] = cvt_pk_bf16(o[4], o[5]); ob[3] = cvt_pk_bf16(o[6], o[7]);
        *(u32x4*)(rCB + off) = ob;
      }
    }
  }
  xcd_barrier(xb);
  { pg8::Gemm g{rK, (const bf16_t*)(ws + WS_WIN) + (size_t)6656 * 1024, NT, 3072, 1024, 1024, rCB, (const bf16_t*)(ws + WS_WPB), 8}; S.init(NT, 3072, gridDim.x, blockIdx.x);
    EpiGate E{D0, D1, rU}; pg8::gemm_phase(lds, g, S, E); }
  xcd_barrier(xb);
  { pg8::Gemm g{rR, (const bf16_t*)(ws + WS_WPA), NT, 1024, 1024, 1024}; S.init(NT, 1024, gridDim.x, blockIdx.x);
    EpiYa E{D0, D1, rU}; pg8::gemm_phase(lds, g, S, E); }
  xcd_barrier(xb);
  { pg8::Gemm g{rU, (const bf16_t*)(ws + WS_WO), NT, 1024, 1024, 1024}; S.init(NT, 1024, gridDim.x, blockIdx.x);
    EpiResB<true> E{xp, xs, nullptr, D0, MOD + 2048, 0}; pg8::gemm_phase(lds, g, S, E); }
  xcd_barrier(xb);
  norm_rows_b16(D0, p.in[7], MOD, 3072, 4096, rV);
  if (gridDim.x != 256) { LAS float* tile = (LAS float*)lds;
    transpose_job<false>(tile, p.in[25], 4096, (bf16_t*)(ws + WS_WFF1), 4096, 1024);
    transpose_job<false>(tile, p.in[26], 1024, (bf16_t*)(ws + WS_WFF2), 1024, 4096); }
  xcd_barrier(xb);
  { pg8::Gemm g{rV, (const bf16_t*)(ws + WS_WFF1), NT, 4096, 1024, 1024}; S.init(NT, 4096, gridDim.x, blockIdx.x);
    EpiFf1 E{rR}; pg8::gemm_phase(lds, g, S, E);
#if REP_P12 > 1
    __syncthreads(); pg8::gemm_phase(lds, g, S, E);
#endif
  }
  xcd_barrier(xb);
  { pg8::Gemm g{rR, (const bf16_t*)(ws + WS_WFF2), 16384, 1024, 4096, 4096}; S.init(16384, 1024, gridDim.x, blockIdx.x);
    EpiResB<false> E{nullptr, nullptr, D0, rV, MOD + 5120, 0}; pg8::gemm_phase(lds, g, S, E); }
  { pg8::Gemm g{rR + (size_t)16384 * 4096, (const bf16_t*)(ws + WS_WFF2), 4096, 1024, 2048, 4096}; S.init(4096, 1024, gridDim.x, blockIdx.x, 2);
    EpiFf2Split E{D0, rV, MOD + 5120, (bf16_t*)(ws + WS_LOR), 16384}; pg8::gemm_phase(lds, g, S, E); }
  xcd_barrier(xb);
  norm_rows<1, true>(nullptr, nullptr, p.in[27], MOD, 5120, 0, (bf16_t*)(ws + WS_LOR), p.out, rV);
}

extern "C" void kernel_launch(void* const* d_in, const int* in_sizes, int n_in,
                              void* d_out, int out_size, void* d_ws, size_t ws_size,
                              hipStream_t stream) {
  static int grid_blocks = 0;
  if (!grid_blocks) {
    int dev = 0, cus = 0, per_cu = 0;
    (void)hipGetDevice(&dev);
    (void)hipDeviceGetAttribute(&cus, hipDeviceAttributeMultiprocessorCount, dev);
    (void)hipFuncSetAttribute((const void*)mega, hipFuncAttributeMaxDynamicSharedMemorySize, LDS_BYTES);
    (void)hipOccupancyMaxActiveBlocksPerMultiprocessor(&per_cu, (const void*)mega, 512, LDS_BYTES);
    if (per_cu < 1) { fprintf(stderr, "occupancy query reports %d blocks per CU\n", per_cu); per_cu = 1; }
    grid_blocks = cus;
    if (ws_size < WS_END + (size_t)8 * 1024 * 1024) fprintf(stderr, "workspace too small: %zu < %zu\n", ws_size, (size_t)WS_END);
  }
  Params p{};
  for (int i = 0; i < 28 && i < n_in; ++i) p.in[i] = (const float*)d_in[i];
  p.out = (float*)d_out;
  p.ws = (unsigned char*)d_ws;
  (void)hipMemsetAsync((unsigned char*)d_ws + WS_BAR, 0, (size_t)3456 * 4, stream);
  void* args[] = {&p};
  hipError_t e = hipLaunchCooperativeKernel((void*)mega, dim3(grid_blocks), dim3(512), args, LDS_BYTES, stream);
  if (e != hipSuccess) fprintf(stderr, "cooperative launch failed: %s (grid %d)\n", hipGetErrorString(e), grid_blocks);
}
```
